# Optimizing an MI355X kernel written in HIP

```python
import jax, jax.numpy as jnp
from jax import lax
import numpy as np

D_MODEL = 4096
BATCH = 2
SEQ = 8192
DEPTH = 1
DEC_BATCH = 8
DEC_SEQ = 32
PAST_LEN = 1024

CHUNK = 64
HG_HEADS = 16
HG_DK = 128
HG_DV = 128
HG_WIDTH = HG_HEADS * HG_DK
CONV_WIDTH = 2048
CONV_K = 3
N_MEM = 256
XA_HEADS = 4
XA_HEAD_DIM = D_MODEL // XA_HEADS
FFN_HIDDEN = ((8 * D_MODEL + 3 * 256 - 1) // (3 * 256)) * 256
PROJ_WIDTH = 4 * HG_WIDTH + 3 * CONV_WIDTH + 2 * D_MODEL
EPS = 1e-6

kernel_name = 'hgrn2_shortconv_gated_streaming_encoder_step'


def rmsnorm(x, g):
    xf = x.astype(jnp.float32)
    y = xf * lax.rsqrt(jnp.mean(xf * xf, axis=-1, keepdims=True) + EPS)
    return (y * g.astype(jnp.float32)).astype(x.dtype)


def hgrn2_recurrence(q, k, v, logf, s0):
    bsz, L, H, _ = q.shape
    C = min(CHUNK, L)
    n = L // C

    def to_chunks(t):
        return t.reshape(bsz, n, C, H, t.shape[-1]).transpose(1, 0, 3, 2, 4)

    causal = jnp.tril(jnp.ones((C, C), dtype=bool))[:, :, None]

    def step(S, inp):
        qc, kc, vc, gc = inp
        b = jnp.cumsum(gc, axis=2)
        o_inter = jnp.einsum('bhtk,bhkv->bhtv', qc * jnp.exp(b), S)
        diff = b[:, :, :, None, :] - b[:, :, None, :, :]
        decay = jnp.exp(jnp.where(causal, diff, -jnp.inf))
        scores = jnp.einsum('bhtk,bhtsk,bhsk->bhts', qc, decay, kc)
        o_intra = jnp.einsum('bhts,bhsv->bhtv', scores, vc)
        b_last = b[:, :, -1:, :]
        S_new = jnp.exp(b_last[:, :, 0, :])[..., None] * S + jnp.einsum('bhsk,bhsv->bhkv', kc * jnp.exp(b_last - b), vc)
        return S_new, o_inter + o_intra

    S_fin, o = lax.scan(step, s0, (to_chunks(q), to_chunks(k), to_chunks(v), to_chunks(logf)))
    o = o.transpose(1, 0, 3, 2, 4).reshape(bsz, L, H, v.shape[-1])
    return o, S_fin


def gated_mixer(h, w_in, lb, hg_norm, conv_w, w_a, w_b, w_o, S0, conv_buf):
    bsz, L, _ = h.shape
    f32 = jnp.float32
    sizes = [HG_WIDTH] * 4 + [CONV_WIDTH] * 3 + [D_MODEL] * 2
    idx = np.cumsum(sizes)[:-1].tolist()
    q, fpre, iv, og, ch, cb, cc, ga, gb = jnp.split(h @ w_in, idx, axis=-1)
    f = lb + (1.0 - lb) * jax.nn.sigmoid(fpre.astype(f32))
    logf = jnp.log(f)
    k = 1.0 - f
    heads = lambda t: t.reshape(bsz, L, HG_HEADS, t.shape[-1] // HG_HEADS)
    o, S_fin = hgrn2_recurrence(heads(q.astype(f32)), heads(k), heads(iv.astype(f32)), heads(logf), S0.astype(f32))
    o = rmsnorm(o, hg_norm.reshape(HG_HEADS, HG_DV)).reshape(bsz, L, HG_WIDTH).astype(h.dtype)
    a = (o * jax.nn.silu(og)) @ w_a
    u = cc * ch
    up = jnp.concatenate([conv_buf.astype(u.dtype), u], axis=1)
    z = sum(conv_w[j] * up[:, j:j + L] for j in range(CONV_K))
    bb = (cb * z) @ w_b
    merged = jax.nn.sigmoid(ga) * a + jax.nn.sigmoid(gb) * bb
    new_buf = up[:, up.shape[1] - (CONV_K - 1):]
    return merged @ w_o, S_fin, new_buf


def memory_kv(mem, g_mem, w_xk, w_xv):
    bsz = mem.shape[0]
    m = rmsnorm(mem, g_mem)
    mk = (m @ w_xk).reshape(bsz, N_MEM, XA_HEADS, XA_HEAD_DIM)
    mv = (m @ w_xv).reshape(bsz, N_MEM, XA_HEADS, XA_HEAD_DIM)
    return mk, mv


def cross_attention(h, mk, mv, w_xq, w_xo):
    bsz, L, _ = h.shape
    q = (h @ w_xq).reshape(bsz, L, XA_HEADS, XA_HEAD_DIM)
    s = jnp.einsum('blhd,bmhd->bhlm', q, mk.astype(q.dtype)).astype(jnp.float32) * (XA_HEAD_DIM ** -0.5)
    p = jax.nn.softmax(s, axis=-1).astype(h.dtype)
    o = jnp.einsum('bhlm,bmhd->blhd', p, mv.astype(h.dtype)).reshape(bsz, L, D_MODEL)
    return o @ w_xo


def swiglu(h, w_gate, w_up, w_down):
    return (jax.nn.silu(h @ w_gate) * (h @ w_up)) @ w_down


def layer(x, g_mix, w_in, lb, hg_norm, conv_w, w_a, w_b, w_o, g_xa, w_xq, w_xo, g_ffn, w_gate, w_up, w_down, S0, conv_buf, mk, mv):
    m, S_fin, new_buf = gated_mixer(rmsnorm(x, g_mix), w_in, lb, hg_norm, conv_w, w_a, w_b, w_o, S0, conv_buf)
    x = x + m
    x = x + cross_attention(rmsnorm(x, g_xa), mk, mv, w_xq, w_xo)
    x = x + swiglu(rmsnorm(x, g_ffn), w_gate, w_up, w_down)
    return x, S_fin, new_buf


def setup_inputs(seed: int = 0) -> dict:
    key = jax.random.key(seed)
    ks = jax.random.split(key, 32)
    f32 = jnp.float32
    nrm = lambda k, shape, scale: jax.random.normal(k, shape, f32) * scale
    gain = lambda k, shape: 1.0 + 0.02 * jax.random.normal(k, shape, f32)
    return {
        'x_prompt': nrm(ks[0], (BATCH, SEQ, D_MODEL), 1.0),
        'x_sample': nrm(ks[1], (DEC_BATCH, DEC_SEQ, D_MODEL), 1.0),
        'cache_mem_k': nrm(ks[2], (DEPTH, DEC_BATCH, N_MEM, XA_HEADS, XA_HEAD_DIM), 1.0),
        'cache_mem_v': nrm(ks[3], (DEPTH, DEC_BATCH, N_MEM, XA_HEADS, XA_HEAD_DIM), 1.0),
        'state_hgrn': nrm(ks[4], (DEPTH, DEC_BATCH, HG_HEADS, HG_DK, HG_DV), 1.0),
        'state_conv': nrm(ks[5], (DEPTH, DEC_BATCH, CONV_K - 1, CONV_WIDTH), 0.5),
        'mem_prompt': nrm(ks[6], (BATCH, N_MEM, D_MODEL), 1.0),
        'norm_mix': gain(ks[7], (DEPTH, D_MODEL)),
        'w_in': nrm(ks[8], (DEPTH, D_MODEL, PROJ_WIDTH), D_MODEL ** -0.5),
        'lb_logits': nrm(ks[9], (DEPTH + 1, HG_WIDTH), 0.5),
        'hg_norm': gain(ks[10], (DEPTH, HG_WIDTH)),
        'conv_w': nrm(ks[11], (DEPTH, CONV_K, CONV_WIDTH), CONV_K ** -0.5),
        'w_a': nrm(ks[12], (DEPTH, HG_WIDTH, D_MODEL), HG_WIDTH ** -0.5),
        'w_b': nrm(ks[13], (DEPTH, CONV_WIDTH, D_MODEL), CONV_WIDTH ** -0.5),
        'w_o': nrm(ks[14], (DEPTH, D_MODEL, D_MODEL), D_MODEL ** -0.5),
        'norm_xattn': gain(ks[15], (DEPTH, D_MODEL)),
        'norm_mem': gain(ks[16], (DEPTH, D_MODEL)),
        'w_xq': nrm(ks[17], (DEPTH, D_MODEL, D_MODEL), D_MODEL ** -0.5),
        'w_xk': nrm(ks[18], (DEPTH, D_MODEL, D_MODEL), D_MODEL ** -0.5),
        'w_xv': nrm(ks[19], (DEPTH, D_MODEL, D_MODEL), D_MODEL ** -0.5),
        'w_xo': nrm(ks[20], (DEPTH, D_MODEL, D_MODEL), D_MODEL ** -0.5),
        'norm_ffn': gain(ks[21], (DEPTH, D_MODEL)),
        'w_gate': nrm(ks[22], (DEPTH, D_MODEL, FFN_HIDDEN), D_MODEL ** -0.5),
        'w_up': nrm(ks[23], (DEPTH, D_MODEL, FFN_HIDDEN), D_MODEL ** -0.5),
        'w_down': nrm(ks[24], (DEPTH, FFN_HIDDEN, D_MODEL), FFN_HIDDEN ** -0.5),
        'norm_final': gain(ks[25], (D_MODEL,)),
    }


def reference(x_prompt, x_sample, cache_mem_k, cache_mem_v, state_hgrn, state_conv, mem_prompt,
              norm_mix, w_in, lb_logits, hg_norm, conv_w, w_a, w_b, w_o,
              norm_xattn, norm_mem, w_xq, w_xk, w_xv, w_xo,
              norm_ffn, w_gate, w_up, w_down, norm_final):
    f32 = jnp.float32
    lb_all = jnp.cumsum(jax.nn.softmax(lb_logits.astype(f32), axis=0), axis=0)
    bp = x_prompt.shape[0]
    xp, xs = x_prompt, x_sample
    mk_list, mv_list, sp_list, cp_list, ss_list, cs_list = [], [], [], [], [], []
    for l in range(DEPTH):
        shared = (norm_mix[l], w_in[l], lb_all[l], hg_norm[l], conv_w[l], w_a[l], w_b[l], w_o[l],
                  norm_xattn[l], w_xq[l], w_xo[l], norm_ffn[l], w_gate[l], w_up[l], w_down[l])
        mk_p, mv_p = memory_kv(mem_prompt, norm_mem[l], w_xk[l], w_xv[l])
        S0 = jnp.zeros((bp, HG_HEADS, HG_DK, HG_DV), f32)
        buf0 = jnp.zeros((bp, CONV_K - 1, CONV_WIDTH), xp.dtype)
        xp, S_p, buf_p = layer(xp, *shared, S0, buf0, mk_p, mv_p)
        xs, S_s, buf_s = layer(xs, *shared, state_hgrn[l], state_conv[l], cache_mem_k[l], cache_mem_v[l])
        mk_list.append(mk_p)
        mv_list.append(mv_p)
        sp_list.append(S_p)
        cp_list.append(buf_p)
        ss_list.append(S_s)
        cs_list.append(buf_s)
    y_prompt = rmsnorm(xp, norm_final)
    y_sample = rmsnorm(xs, norm_final)
    return (y_prompt, y_sample, jnp.stack(mk_list), jnp.stack(mv_list), jnp.stack(sp_list), jnp.stack(cp_list), jnp.stack(ss_list), jnp.stack(cs_list))
```

```cpp
#include <hip/hip_runtime.h>
#include <cstdio>
#include <cstdint>

#ifndef MK_ONE_LAUNCH
#define MK_ONE_LAUNCH 1
#endif

#define LAS __attribute__((address_space(3)))
#define GAS __attribute__((address_space(1)))
typedef unsigned short bf16_t;
typedef short bf16x8 __attribute__((ext_vector_type(8)));
typedef float f32x4 __attribute__((ext_vector_type(4)));
typedef float f32x2 __attribute__((ext_vector_type(2)));
typedef unsigned u32x4 __attribute__((ext_vector_type(4)));
typedef int i32x4 __attribute__((ext_vector_type(4)));

typedef unsigned u32x2 __attribute__((ext_vector_type(2)));

constexpr int D = 4096, SEQ = 8192, NB = 2, DECB = 8, DECS = 32;
constexpr int MP = NB * SEQ;
constexpr int MS = DECB * DECS;
constexpr int M = MP + MS;
constexpr int HGW = 2048, NH = 16, DK = 128, DV = 128;
constexpr int CW = 2048;
constexpr int NMEM = 256, XH = 4, XD = 1024;
constexpr int FF = 11008;
constexpr int PROJW = 22528;
constexpr float EPS = 1e-6f;
constexpr int PW = 18432;
constexpr int PC_Q = 0, PC_CB = 2048, PC_U = 4096, PC_IV = 6144, PC_OG = 8192, PC_GA = 10240, PC_GB = 14336;
constexpr int NCHUNK = SEQ / 64;
constexpr int NSLOT_P = NB * NH * NCHUNK;
constexpr int NSLOT = NSLOT_P + DECB * NH;

constexpr size_t O_Y = 0, O_MK = (size_t)M * D, O_MV = O_MK + (size_t)NB * NMEM * D, O_HP = O_MV + (size_t)NB * NMEM * D,
                 O_CP = O_HP + (size_t)NB * NH * DK * DV, O_HS = O_CP + (size_t)NB * 2 * CW, O_CS = O_HS + (size_t)DECB * NH * DK * DV;

constexpr size_t MiB = 1u << 20;
constexpr size_t WS_CTL = 0, CTL_ZERO_BYTES = 1 * MiB;
constexpr int CW_BAR = 4096;
constexpr int CW_SUB = 8192;
constexpr int NSC = 16;
constexpr size_t WS_SS1 = 256 * 1024, WS_SS2 = 384 * 1024, WS_SS3 = 512 * 1024;
constexpr size_t WS_SBMAX = 640 * 1024;
constexpr size_t WS_SBMAXI = 768 * 1024;
constexpr size_t WS_SBMAXQ = 832 * 1024, WS_SBMAXO = 848 * 1024;
constexpr size_t WS_LB = 1 * MiB;
constexpr size_t WS_SA = 7 * MiB;
constexpr size_t WS_SB = 7 * MiB + 128 * 1024;
constexpr size_t WS_SAI = 7 * MiB + 256 * 1024;
constexpr size_t WS_SA1 = 7 * MiB + 512 * 1024, WS_SAO = 7 * MiB + 640 * 1024;
constexpr size_t WS_SBQ = 7 * MiB + 768 * 1024, WS_SBO = 7 * MiB + 800 * 1024;
constexpr size_t WS_SBI = 7 * MiB + 384 * 1024;
constexpr size_t WS_DEC = 2 * MiB;
constexpr size_t WS_LSUM = 5 * MiB;
constexpr size_t WS_MEMB = 8 * MiB;
constexpr size_t WS_MKB = 12 * MiB;
constexpr size_t WS_MVB = 16 * MiB;
constexpr size_t WS_MKS = 20 * MiB;
constexpr size_t WS_VTS = 36 * MiB;
constexpr size_t WS_WAB = 52 * MiB, WS_WO = 84 * MiB, WS_WXQ = 116 * MiB, WS_WKV = 148 * MiB, WS_WXO = 212 * MiB, WS_WGU = 244 * MiB, WS_WD = 416 * MiB;
constexpr size_t WS_WIN = 502 * MiB;
constexpr size_t WS_WIN8 = 582 * MiB;
constexpr size_t WS_XB = 678 * MiB;
constexpr size_t WS_ST = 502 * MiB;
constexpr size_t WS_PROJ = 808 * MiB;
constexpr size_t WS_LOGF = 1393 * MiB;
constexpr size_t WS_XBQ = 1523 * MiB;
constexpr size_t WS_WXQRM = 330 * MiB;
constexpr size_t WS_WXOT = 362 * MiB;
constexpr size_t WS_WPT = 394 * MiB;
constexpr size_t WS_VP = 132 * MiB;
constexpr size_t WS_END = 1588 * MiB;
constexpr size_t WS_MERGED = 502 * MiB;
constexpr size_t WS_X1B = 632 * MiB;
constexpr size_t WS_PB = 762 * MiB;
constexpr size_t WS_QX = 1393 * MiB;
constexpr size_t WS_OX = 502 * MiB;
constexpr size_t WS_X2Q = 502 * MiB;
constexpr size_t WS_GU = 808 * MiB;
static_assert(WS_WD + (size_t)D * FF * 2 <= WS_WIN && WS_WIN + (size_t)10240 * D * 2 <= WS_WIN8 && WS_WIN8 + (size_t)14336 * D <= WS_XB && WS_XB + (size_t)M * D * 2 <= WS_PROJ && WS_XBQ + (size_t)M * D <= WS_END, "ws map 1");
static_assert(WS_ST + (size_t)NSLOT * DK * DV * 4 <= WS_PROJ && WS_PROJ + (size_t)M * PW * 2 <= WS_LOGF && WS_LOGF + (size_t)M * HGW * 4 <= WS_END, "ws map 2");
static_assert(WS_PB + (size_t)M * 1024 * 2 <= WS_PROJ && WS_GU + (size_t)M * FF * 2 <= WS_LOGF, "ws map 3");

constexpr size_t DO_X1Q = 0, DO_OXQ = 80 * MiB;

constexpr int RING_BYTES = 131072;
constexpr int LDSX_OFF = RING_BYTES;
constexpr int MISC_OFF = RING_BYTES + 8192;
constexpr int RSC_OFF = MISC_OFF + 256;
constexpr int LDS_BYTES = RSC_OFF + 16384;
constexpr int NWAVES = 8;

typedef __bf16 bf16x2_n __attribute__((ext_vector_type(2)));
__device__ __forceinline__ unsigned pk2(float lo, float hi) { return __builtin_bit_cast(unsigned, __builtin_convertvector((f32x2){lo, hi}, bf16x2_n)); }
__device__ __forceinline__ unsigned f2bf(float f) { return pk2(f, 0.f) & 0xffffu; }
__device__ __forceinline__ unsigned cvt_pk_bf16(float lo, float hi) { unsigned r; asm volatile("s_nop 0\n\tv_cvt_pk_bf16_f32 %0, %1, %2" : "=v"(r) : "v"(lo), "v"(hi)); return r; }
__device__ __forceinline__ float bf_lo(unsigned w) { return __builtin_bit_cast(float, w << 16); }
__device__ __forceinline__ float bf_hi(unsigned w) { return __builtin_bit_cast(float, w & 0xffff0000u); }
__device__ __forceinline__ float fast_rcp(float x) { return __builtin_amdgcn_rcpf(x); }
__device__ __forceinline__ float fast_exp2(float x) { return __builtin_amdgcn_exp2f(x); }
__device__ __forceinline__ float sigmoid_f(float x) { return fast_rcp(1.0f + fast_exp2(-1.44269504089f * x)); }
__device__ __forceinline__ float wave_sum(float v) {
#pragma unroll
    for (int o = 1; o < 64; o <<= 1) v += __shfl_xor(v, o);
    return v;
}
#define LDS_WAIT() asm volatile("s_waitcnt lgkmcnt(0)" ::: "memory")
#define VM_WAIT() asm volatile("s_waitcnt vmcnt(0)" ::: "memory")

namespace pg8 {
constexpr int BM = 256, BK = 64, HALF = 128, HTB = HALF * BK * 2, STAGE_BYTES = 8 * HTB, NXCD = 8, WGM = 4;
__host__ __device__ __forceinline__ int lds_byte(int r, int c) { const int st = (r >> 4) * 2 + (c >> 5), rr = r & 15, cc = c & 31, ob = rr * 64 + cc * 2; return st * 1024 + (ob ^ (((ob >> 9) & 1) << 5)); }
__host__ __device__ __forceinline__ void stage_rc(int b, int& R, int& C) { const int st = b / 1024, sb = b % 1024, swz = sb ^ (((sb >> 9) & 1) << 5); R = (st >> 1) * 16 + swz / 64; C = (st & 1) * 32 + (swz % 64) / 2; }
__host__ __device__ __forceinline__ int perm32(int rho) { const int n = rho >> 4, i = rho & 15; return 8 * (i >> 2) + 4 * n + (i & 3); }

struct Unit { int pm, pn, z; };

__device__ __forceinline__ void static_unit(int L, int nM, int nN, Unit& u) {
    const int nwg = nM * nN; int wgid = L;
    { const int q = nwg / NXCD, r = nwg % NXCD, xcd = wgid % NXCD, off = wgid / NXCD; wgid = (xcd < r ? xcd * (q + 1) : r * (q + 1) + (xcd - r) * q) + off; }
    const int nig = WGM * nN, gid = wgid / nig, fm = gid * WGM, gsz = (nM - fm) < WGM ? (nM - fm) : WGM;
    u.pm = fm + ((wgid % nig) % gsz); u.pn = (wgid % nig) / gsz;
}

typedef f32x4 Acc[2][2][4][2];

template <class Prob, bool ALIGN = true>
__device__ __forceinline__ void gemm_phase(LAS unsigned char* lds, const Prob& P) {
    int tid = threadIdx.x; asm volatile("" : "+v"(tid));
    const int wid = __builtin_amdgcn_readfirstlane(tid >> 6), lane = tid & 63, wr = wid >> 2, wc = wid & 3, fr = lane & 15, fq = lane >> 4;
    const int nt = P.nt;
    const unsigned lda = P.lda, ldb = P.ldb;
    unsigned voffA[2], voffB[2];
#pragma unroll
    for (int i = 0; i < 2; ++i) { int R, C; stage_rc(tid * 16 + i * 8192, R, C); const int Rb = (R & ~31) + perm32(R & 31);
        voffA[i] = (unsigned)R * lda + (unsigned)C * 2u; voffB[i] = (unsigned)Rb * ldb + (unsigned)C * 2u; }
    const size_t kstep = (size_t)(BK * 2);
    const size_t hstepA = (size_t)HALF * lda, hstepB = (size_t)HALF * ldb;
    const unsigned ldsw = (unsigned)wid * 1024u;
    const int aoff = lds_byte(wr * 64 + fr, fq * 8), boff = lds_byte(wc * 32 + fr, fq * 8);
#define PG8_SA(b, h) (((b) * 2 + (h)) * HTB)
#define PG8_SB(b, h) ((4 + (b) * 2 + (h)) * HTB)
#define PG8_STAGE(bufoff, gbase, voff) do { _Pragma("unroll") for (int _i = 0; _i < 2; ++_i) \
        __builtin_amdgcn_global_load_lds((const unsigned*)((const char*)(gbase) + (voff)[_i]), (LAS unsigned*)(lds + (bufoff) + ldsw + _i * 8192), 16, 0, 0); } while (0)
#define PG8_LDA(dst, b, h) do { _Pragma("unroll") for (int m = 0; m < 4; ++m) _Pragma("unroll") for (int k = 0; k < 2; ++k) dst[m][k] = *(const LAS bf16x8*)(lds + PG8_SA(b, h) + aoff + m * 2048 + k * 1024); } while (0)
#define PG8_LDB(dst, b, h) do { _Pragma("unroll") for (int n = 0; n < 2; ++n) _Pragma("unroll") for (int k = 0; k < 2; ++k) dst[n][k] = *(const LAS bf16x8*)(lds + PG8_SB(b, h) + boff + n * 2048 + k * 1024); } while (0)
#define PG8_MMA(ai, bj, At, Bt) do { __builtin_amdgcn_s_setprio(1); _Pragma("unroll") for (int m = 0; m < 4; ++m) _Pragma("unroll") for (int n = 0; n < 2; ++n) _Pragma("unroll") for (int k = 0; k < 2; ++k) \
        { if constexpr (Prob::I8) acc[ai][bj][m][n] = __builtin_bit_cast(f32x4, __builtin_amdgcn_mfma_i32_16x16x64_i8(__builtin_bit_cast(i32x4, Bt[n][k]), __builtin_bit_cast(i32x4, At[m][k]), __builtin_bit_cast(i32x4, acc[ai][bj][m][n]), 0, 0, 0)); \
          else acc[ai][bj][m][n] = __builtin_amdgcn_mfma_f32_16x16x32_bf16(Bt[n][k], At[m][k], acc[ai][bj][m][n], 0, 0, 0); } __builtin_amdgcn_s_setprio(0); } while (0)
#define PG8_WAIT_V(n) asm volatile("s_waitcnt vmcnt(" #n ")" ::: "memory")
#define PG8_WAIT_L(n) asm volatile("s_waitcnt lgkmcnt(" #n ")" ::: "memory")
#define PG8_BAR __builtin_amdgcn_s_barrier()
#define PG8_SCHED __builtin_amdgcn_sched_barrier(0)
    Unit cur, nxt; int ui = 0;
    if (!P.next(0, cur)) return;
    Acc acc;
#pragma unroll
    for (int a = 0; a < 2; ++a)
#pragma unroll
        for (int b = 0; b < 2; ++b)
#pragma unroll
            for (int m = 0; m < 4; ++m)
#pragma unroll
                for (int n = 0; n < 2; ++n) acc[a][b][m][n] = (f32x4){0.f, 0.f, 0.f, 0.f};
    bf16x8 At[4][2], B0[2][2], B1[2][2];
    const char* cA = P.a_ptr(cur); const char* cB = P.b_ptr(cur);
    PG8_STAGE(PG8_SB(0, 0), cB, voffB); PG8_STAGE(PG8_SB(0, 1), cB + hstepB, voffB); PG8_STAGE(PG8_SA(0, 0), cA, voffA); PG8_STAGE(PG8_SA(0, 1), cA + hstepA, voffA);
    if (wr == 1) PG8_BAR;
    PG8_WAIT_V(2); PG8_BAR;
    PG8_STAGE(PG8_SB(1, 0), cB + kstep, voffB); PG8_STAGE(PG8_SA(1, 0), cA + kstep, voffA); PG8_STAGE(PG8_SB(1, 1), cB + hstepB + kstep, voffB);
    PG8_WAIT_V(6); PG8_BAR;
    for (;;) {
        const bool has_next = P.next(ui + 1, nxt);
        const char* nA = has_next ? P.a_ptr(nxt) : cA; const char* nB = has_next ? P.b_ptr(nxt) : cB;
        for (int t = 0; t < nt; t += 2) {
            const bool last = (t == nt - 2);
            const char* a1 = cA + (size_t)(t + 1) * kstep;
            const char* a2 = last ? nA : cA + (size_t)(t + 2) * kstep; const char* b2 = last ? nB : cB + (size_t)(t + 2) * kstep;
            const char* a3 = a2 + kstep; const char* b3 = b2 + kstep;
            if constexpr (Prob::HAS_MID) { if (t == (nt >> 1)) P.mid(acc, cur, wr, wc, fr, fq); }
            PG8_LDB(B0, 0, 0); PG8_LDB(B1, 0, 1); PG8_SCHED; PG8_LDA(At, 0, 0); PG8_STAGE(PG8_SA(1, 1), a1 + hstepA, voffA);
            PG8_WAIT_V(8); PG8_WAIT_L(0); PG8_BAR; PG8_MMA(0, 0, At, B0); PG8_MMA(0, 1, At, B1); PG8_BAR; PG8_SCHED;
            PG8_LDA(At, 0, 1); PG8_STAGE(PG8_SB(0, 0), b2, voffB); PG8_STAGE(PG8_SB(0, 1), b2 + hstepB, voffB); PG8_STAGE(PG8_SA(0, 0), a2, voffA);
            PG8_WAIT_V(8); PG8_WAIT_L(0); PG8_BAR; PG8_MMA(1, 0, At, B0); PG8_MMA(1, 1, At, B1); PG8_BAR; PG8_SCHED;
            PG8_LDB(B0, 1, 0); PG8_LDB(B1, 1, 1); PG8_SCHED; PG8_LDA(At, 1, 0); PG8_STAGE(PG8_SA(0, 1), a2 + hstepA, voffA);
            PG8_WAIT_V(8); PG8_WAIT_L(0); PG8_BAR; PG8_MMA(0, 0, At, B0); PG8_MMA(0, 1, At, B1); PG8_BAR; PG8_SCHED;
            PG8_LDA(At, 1, 1); PG8_STAGE(PG8_SB(1, 0), b3, voffB); PG8_STAGE(PG8_SB(1, 1), b3 + hstepB, voffB); PG8_STAGE(PG8_SA(1, 0), a3, voffA);
            PG8_WAIT_V(8); PG8_WAIT_L(0); PG8_BAR; PG8_MMA(1, 0, At, B0); PG8_MMA(1, 1, At, B1); PG8_BAR; PG8_SCHED;
        }
        if constexpr (ALIGN) { if (wr == 0) PG8_BAR; }
        P.epi(acc, cur, wr, wc, fr, fq, wid, lane);
        if (!has_next) break;
#pragma unroll
        for (int a = 0; a < 2; ++a)
#pragma unroll
            for (int b = 0; b < 2; ++b)
#pragma unroll
                for (int m = 0; m < 4; ++m)
#pragma unroll
                    for (int n = 0; n < 2; ++n) acc[a][b][m][n] = (f32x4){0.f, 0.f, 0.f, 0.f};
        cur = nxt; cA = nA; cB = nB; ++ui;
        if constexpr (ALIGN) { if (wr == 1) PG8_BAR; }
    }
    PG8_WAIT_V(0);
    if constexpr (!ALIGN) { if (wr == 0) PG8_BAR; }
    PG8_BAR;
#undef PG8_SA
#undef PG8_SB
#undef PG8_STAGE
#undef PG8_LDA
#undef PG8_LDB
#undef PG8_MMA
#undef PG8_WAIT_V
#undef PG8_WAIT_L
#undef PG8_BAR
#undef PG8_SCHED
}
}
using pg8::Unit; using pg8::Acc;

#define XB_TMO      128
#define XB_XCNT(j)  (256  + 64 * (j))
#define XB_XSUB(j)  (1280 + 64 * (j))
#define XB_XGEN(j)  (2304 + 64 * (j))
#define XB_TOP      3328
#define XB_TOPGEN   3392
#define XCD_BAR_WORDS 3456
#define XB_SPIN_CAP (1u << 18)
__device__ __forceinline__ unsigned xb_ld(unsigned* p)              { return __hip_atomic_load(p, __ATOMIC_RELAXED, __HIP_MEMORY_SCOPE_AGENT); }
__device__ __forceinline__ unsigned xb_add(unsigned* p, unsigned v) { return __hip_atomic_fetch_add(p, v, __ATOMIC_RELAXED, __HIP_MEMORY_SCOPE_AGENT); }
__device__ __forceinline__ unsigned xb_xcc_id() { return (unsigned)__builtin_amdgcn_s_getreg((3 << 11) | 20) & 0xFu; }
#define XB_SPIN(cond, bar) do { unsigned _sp = 0; while (cond) { __builtin_amdgcn_s_sleep(1); \
    if ((++_sp & 255u) == 0u) { if (xb_ld(&(bar)[XB_TMO])) break; if (_sp > XB_SPIN_CAP) { atomicAdd(&(bar)[XB_TMO], 1u); break; } } } } while (0)
struct XcdBarrier { unsigned* bar; unsigned x; volatile LAS unsigned* st; };
__device__ __forceinline__ XcdBarrier xcd_barrier_post(unsigned* bar, volatile LAS unsigned* st) {
    XcdBarrier b; b.bar = bar; b.x = xb_xcc_id(); b.st = st;
    if (threadIdx.x == 0) (void)xb_add(&bar[XB_XCNT(b.x)], 1u);
    return b;
}
__device__ __forceinline__ void xcd_barrier_complete(unsigned* bar, unsigned x, unsigned& nloc, unsigned& nx) {
    const unsigned G = gridDim.x * gridDim.y * gridDim.z;
    unsigned sum, cnt, mine, sp = 0u;
    for (;;) {
        sum = 0u; cnt = 0u; mine = 0u;
#pragma unroll
        for (unsigned j = 0; j < 16; ++j) { const unsigned c = xb_ld(&bar[XB_XCNT(j)]); sum += c; cnt += (c > 0u) ? 1u : 0u; mine = (j == x) ? c : mine; }
        if (sum == G) break;
        __builtin_amdgcn_s_sleep(1);
        if ((++sp & 255u) == 0u) { if (xb_ld(&bar[XB_TMO])) break; if (sp > XB_SPIN_CAP) { atomicAdd(&bar[XB_TMO], 1u); break; } }
    }
    nloc = mine > 0u ? mine : 1u; nx = cnt > 0u ? cnt : 1u;
}
__device__ __forceinline__ void xcd_barrier(const XcdBarrier& b) {
    asm volatile("s_waitcnt vmcnt(0)" ::: "memory");
    __syncthreads();
    if (threadIdx.x == 0) {
        unsigned* bar = b.bar;
        __builtin_amdgcn_s_waitcnt(0);
        unsigned nloc = b.st[0], nx = b.st[1];
        if (nloc == 0u) { xcd_barrier_complete(bar, b.x, nloc, nx); b.st[0] = nloc; b.st[1] = nx; }
        const unsigned old = xb_add(&bar[XB_XSUB(b.x)], 1u);
        const unsigned gen = old / nloc;
        if (old + 1u == (gen + 1u) * nloc) {
            __builtin_amdgcn_fence(__ATOMIC_RELEASE, "agent");
            asm volatile("s_waitcnt vmcnt(0)" ::: "memory");
            const unsigned og = xb_add(&bar[XB_TOP], 1u);
            const unsigned tg = og / nx;
            if (og + 1u == (tg + 1u) * nx) xb_add(&bar[XB_TOPGEN], 1u);
            else XB_SPIN(xb_ld(&bar[XB_TOPGEN]) == tg, bar);
            __builtin_amdgcn_fence(__ATOMIC_ACQUIRE, "agent");
            xb_add(&bar[XB_XGEN(b.x)], 1u);
            asm volatile("s_waitcnt vmcnt(0)" ::: "memory");
        } else {
            XB_SPIN(xb_ld(&bar[XB_XGEN(b.x)]) == gen, bar);
            __builtin_amdgcn_fence(__ATOMIC_ACQUIRE, "agent");
            asm volatile("s_waitcnt vmcnt(0)" ::: "memory");
        }
    }
    __syncthreads();
}

__device__ __forceinline__ void sub_barrier(unsigned* w, unsigned n, unsigned& gen, unsigned* tmo) {
    asm volatile("s_waitcnt vmcnt(0)" ::: "memory");
    __syncthreads();
    if (threadIdx.x == 0) {
        __builtin_amdgcn_fence(__ATOMIC_RELEASE, "agent");
        asm volatile("s_waitcnt vmcnt(0)" ::: "memory");
        (void)xb_add(w, 1u);
        const unsigned target = (gen + 1u) * n; unsigned sp = 0;
        while (xb_ld(w) < target) { __builtin_amdgcn_s_sleep(1); if ((++sp & 255u) == 0u) { if (xb_ld(tmo)) break; if (sp > XB_SPIN_CAP) { atomicAdd(tmo, 1u); break; } } }
        __builtin_amdgcn_fence(__ATOMIC_ACQUIRE, "agent");
        asm volatile("s_waitcnt vmcnt(0)" ::: "memory");
    }
    ++gen;
    __syncthreads();
}

struct Args { const float* in[26]; float* out; unsigned char* ws; int ph_lo, ph_hi; };
enum { I_XP = 0, I_XS, I_CK, I_CV, I_SH, I_SC, I_MEM, I_NMIX, I_WIN, I_LBL, I_HGN, I_CONVW, I_WA, I_WB, I_WO, I_NXA, I_NMEM, I_WXQ, I_WXK, I_WXV, I_WXO, I_NFFN, I_WG, I_WU, I_WDN, I_NFIN };

struct Frame {
    LAS unsigned char* lds;
    int tid, lane, wave, G, bid;
    const float* const* in; float* out; unsigned char* ws;
};

struct CvtJob { const float* W; int ldw, k0, n0; bf16_t* WT; int ldd, drow0, dk0; const float* gain; };
__device__ __forceinline__ void cvt_load(const CvtJob& j, f32x4 (&v)[8], int lane) {
#pragma unroll
    for (int i = 0; i < 8; ++i) v[i] = *(const f32x4*)(j.W + (size_t)(j.k0 + 8 * i + (lane >> 3)) * j.ldw + j.n0 + 4 * (lane & 7));
}
__device__ __forceinline__ void cvt_store(const CvtJob& j, const f32x4 (&v)[8], LAS float* scr, int lane) {
#pragma unroll
    for (int i = 0; i < 8; ++i) { LAS float* d = scr + (8 * i + (lane >> 3)) * 33 + 4 * (lane & 7); d[0] = v[i][0]; d[1] = v[i][1]; d[2] = v[i][2]; d[3] = v[i][3]; }
    LDS_WAIT(); asm volatile("" ::: "memory");
    const int c = lane & 7;
    float g[8];
#pragma unroll
    for (int i = 0; i < 8; ++i) g[i] = j.gain ? j.gain[j.k0 + 8 * c + i] : 1.0f;
#pragma unroll
    for (int q = 0; q < 4; ++q) { const int n = (lane >> 3) + 8 * q; const LAS float* s = scr + (8 * c) * 33 + n;
        u32x4 o; o.x = cvt_pk_bf16(s[0 * 33] * g[0], s[1 * 33] * g[1]); o.y = cvt_pk_bf16(s[2 * 33] * g[2], s[3 * 33] * g[3]); o.z = cvt_pk_bf16(s[4 * 33] * g[4], s[5 * 33] * g[5]); o.w = cvt_pk_bf16(s[6 * 33] * g[6], s[7 * 33] * g[7]);
        *(u32x4*)(j.WT + (size_t)(j.drow0 + n) * j.ldd + j.dk0 + j.k0 + 8 * c) = o; }
    LDS_WAIT(); asm volatile("" ::: "memory");
}
__device__ __forceinline__ int win_src0(int seg) { return seg == 0 ? 0 : seg == 1 ? 8192 : seg == 2 ? 12288 : seg == 3 ? 4096 : 2048; }
__device__ __forceinline__ int win_dst(int seg, int j) {
    if (seg == 0) return j;
    if (seg == 1) return 2048 + 256 * (j >> 7) + (j & 127);
    if (seg == 2) return 2048 + 256 * (j >> 7) + 128 + (j & 127);
    if (seg == 3) return 6144 + j;
    return 8192 + j;
}
__device__ __forceinline__ void norm_row_to_bf16(const float* xrow, const float* gain, bf16_t* orow, int lane, unsigned char* qrow = nullptr, float* sa = nullptr) {
    const f32x4* xr = (const f32x4*)xrow + lane; const f32x4* gr = (const f32x4*)gain + lane;
    f32x4 v[16]; float s = 0.f;
#pragma unroll
    for (int j = 0; j < 16; ++j) { v[j] = xr[64 * j]; s += (v[j].x * v[j].x + v[j].y * v[j].y) + (v[j].z * v[j].z + v[j].w * v[j].w); }
    const float rstd = 1.0f / sqrtf(wave_sum(s) * (1.0f / D) + EPS);
    u32x2* o8 = (u32x2*)orow + lane; float mx = 0.f;
#pragma unroll
    for (int j = 0; j < 16; ++j) { const f32x4 g = gr[64 * j]; v[j] = v[j] * rstd * g; u32x2 w; w.x = pk2(v[j].x, v[j].y); w.y = pk2(v[j].z, v[j].w); o8[64 * j] = w;
        mx = fmaxf(mx, fmaxf(fmaxf(fabsf(v[j].x), fabsf(v[j].y)), fmaxf(fabsf(v[j].z), fabsf(v[j].w)))); }
    if (qrow) {
#pragma unroll
        for (int o = 1; o < 64; o <<= 1) mx = fmaxf(mx, __shfl_xor(mx, o));
        const float inv = mx > 0.f ? 127.0f / mx : 0.f; unsigned* q4 = (unsigned*)qrow + lane;
#pragma unroll
        for (int j = 0; j < 16; ++j) q4[64 * j] = ((unsigned)(int)__builtin_rintf(v[j].x * inv) & 0xffu) | (((unsigned)(int)__builtin_rintf(v[j].y * inv) & 0xffu) << 8) | (((unsigned)(int)__builtin_rintf(v[j].z * inv) & 0xffu) << 16) | (((unsigned)(int)__builtin_rintf(v[j].w * inv) & 0xffu) << 24);
        if (lane == 0) *sa = mx * (1.0f / 127.0f);
    }
}
constexpr int IT_WIN = (D / 64) * (8192 / 32), IT_WIN8 = (D / 64) * (14336 / 32), IT_WA = (HGW / 64) * (D / 32), IT_SQ = (D / 64) * (D / 32), IT_GU = (D / 64) * (FF / 32), IT_WD = (FF / 64) * (D / 32), IT_CV = (NMEM / 64) * (D / 32);
constexpr int NIT_W = IT_WIN + 2 * IT_WA + 4 * IT_SQ + IT_WD + DECB * IT_CV;

__device__ __forceinline__ CvtJob cvt_job(const Frame& F, int it) {
    unsigned char* ws = F.ws; CvtJob j; int r = it;
#define CVT_SET(W_, ldw_, nb_, WT_, ldd_, drow_, dk_, gain_) do { const int kb = r / (nb_), n0 = (r % (nb_)) * 32; j.W = (W_); j.ldw = (ldw_); j.k0 = kb * 64; j.n0 = n0; j.WT = (bf16_t*)(WT_); j.ldd = (ldd_); j.drow0 = (drow_); j.dk0 = (dk_); j.gain = (gain_); return j; } while (0)
    if (r < IT_WIN) { const int kb = r / 256, cbk = r % 256 + 64, seg = cbk >> 6, j0 = (cbk & 63) * 32;
        j.W = F.in[I_WIN]; j.ldw = PROJW; j.k0 = kb * 64; j.n0 = win_src0(seg) + j0; j.WT = (bf16_t*)(ws + WS_WIN); j.ldd = D; j.drow0 = win_dst(seg, j0); j.dk0 = 0; j.gain = nullptr; return j; } r -= IT_WIN;
    if (r < IT_SQ) CVT_SET(F.in[I_WXK], D, D / 32, ws + WS_WKV, D, n0, 0, nullptr); r -= IT_SQ;
    if (r < IT_SQ) CVT_SET(F.in[I_WXV], D, D / 32, ws + WS_WKV, D, D + n0, 0, nullptr); r -= IT_SQ;
    if (r < DECB * IT_CV) { const int sidx = r / IT_CV; r = r % IT_CV; CVT_SET(F.in[I_CV] + (size_t)sidx * NMEM * D, D, D / 32, ws + WS_VTS + (size_t)sidx * D * NMEM * 2, NMEM, n0, 0, nullptr); } r -= DECB * IT_CV;
    if (r < IT_WA) CVT_SET(F.in[I_WA], D, D / 32, ws + WS_WAB, D, n0, 0, nullptr); r -= IT_WA;
    if (r < IT_WA) CVT_SET(F.in[I_WB], D, D / 32, ws + WS_WAB, D, n0, HGW, nullptr); r -= IT_WA;
    if (r < IT_SQ) CVT_SET(F.in[I_WO], D, D / 32, ws + WS_WO, D, n0, 0, nullptr); r -= IT_SQ;
    if (r < IT_WD) CVT_SET(F.in[I_WDN], D, D / 32, ws + WS_WD, FF, n0, 0, nullptr); r -= IT_WD;
    CVT_SET(F.in[I_WXO], D, D / 32, ws + WS_WXOT, D, n0, 0, nullptr);
#undef CVT_SET
}
__device__ __forceinline__ void convert_items(Frame& F, int lo, int hi, int w, int NW) {
    LAS float* scr = (LAS float*)(F.lds + F.wave * 16384);
    int it = lo + w; if (it >= hi) return;
    CvtJob cur = cvt_job(F, it); f32x4 v[8]; cvt_load(cur, v, F.lane);
    for (;;) {
        const int nx = it + NW; const bool more = nx < hi;
        CvtJob nj = cur; f32x4 vn[8];
        if (more) { nj = cvt_job(F, nx); cvt_load(nj, vn, F.lane); }
        cvt_store(cur, v, scr, F.lane);
        if (!more) break;
#pragma unroll
        for (int i = 0; i < 8; ++i) v[i] = vn[i];
        cur = nj; it = nx;
    }
}
constexpr int NIT_P0 = IT_WIN + 2 * IT_SQ + DECB * IT_CV;
static_assert(NIT_P0 + 2 * IT_WA + 2 * IT_SQ + IT_WD == NIT_W, "item list");

constexpr int NIT_Q8 = 2 * IT_GU + IT_WIN8 + IT_SQ;
struct Q8Job { const float* W; int ldw, k0, n0, drow0; const float* gain; unsigned* smax; float* sb; unsigned char* WQ; };
__device__ __forceinline__ Q8Job q8_job(const Frame& F, int it) {
    Q8Job j; unsigned char* ws = F.ws;
    if (it < 2 * IT_GU) { const int mat = it >= IT_GU ? 1 : 0, r = it - mat * IT_GU, nb = FF / 32, kb = r / nb, n0 = (r % nb) * 32;
        j.W = F.in[mat ? I_WU : I_WG]; j.ldw = FF; j.k0 = kb * 64; j.n0 = n0; j.drow0 = 256 * (n0 >> 7) + 128 * mat + (n0 & 127); j.gain = F.in[I_NFFN];
        j.smax = (unsigned*)(ws + WS_SBMAX); j.sb = (float*)(ws + WS_SB); j.WQ = ws + WS_WGU; return j; }
    if (it >= 2 * IT_GU + IT_WIN8) { const int r = it - (2 * IT_GU + IT_WIN8), nb = D / 32, kb = r / nb, n0 = (r % nb) * 32;
        j.W = F.in[I_WXQ]; j.ldw = D; j.k0 = kb * 64; j.n0 = n0; j.drow0 = n0; j.gain = F.in[I_NXA];
        j.smax = (unsigned*)(ws + WS_SBMAXQ); j.sb = (float*)(ws + WS_SBQ); j.WQ = ws + WS_WXQ; return j; }
    const int r = it - 2 * IT_GU, kb = r / 448, cb = r % 448;
    int src0, dst0, j0;
    if (cb < 64) { src0 = 10240; dst0 = 0; j0 = cb * 32; } else if (cb < 128) { src0 = 6144; dst0 = 2048; j0 = (cb - 64) * 32; }
    else if (cb < 256) { src0 = 14336; dst0 = 4096; j0 = (cb - 128) * 32; } else if (cb < 384) { src0 = 18432; dst0 = 8192; j0 = (cb - 256) * 32; } else { src0 = 0; dst0 = 12288; j0 = (cb - 384) * 32; }
    j.W = F.in[I_WIN]; j.ldw = PROJW; j.k0 = kb * 64; j.n0 = src0 + j0; j.drow0 = dst0 + j0; j.gain = nullptr;
    j.smax = (unsigned*)(ws + WS_SBMAXI); j.sb = (float*)(ws + WS_SBI); j.WQ = ws + WS_WIN8; return j;
}
__device__ __forceinline__ void q8_load(const Q8Job& j, f32x4 (&v)[8], float (&g)[8], int lane) {
#pragma unroll
    for (int i = 0; i < 8; ++i) { const int k = j.k0 + 8 * i + (lane >> 3); v[i] = *(const f32x4*)(j.W + (size_t)k * j.ldw + j.n0 + 4 * (lane & 7)); g[i] = j.gain ? j.gain[k] : 1.0f; }
}
__device__ __forceinline__ void q8_cm_load(const float* p, size_t ldw, const float* gain, int k, f32x4 (&v)[8], float (&g)[8]) {
#pragma unroll
    for (int i = 0; i < 8; ++i) { v[i] = *(const f32x4*)(p + (size_t)i * ldw); g[i] = gain ? gain[k + i] : 1.0f; }
}
__device__ __forceinline__ void q8_colmax(Frame& F, int lo, int hi, int w, int NW) {
    const int lane = F.lane;
    for (int it = lo + 8 * w; it < hi; it += 8 * NW) {
        const Q8Job j = q8_job(F, it); const int drow_l = q8_job(F, it + (lane >> 3)).drow0;
        const float* p = j.W + (size_t)j.k0 * j.ldw + j.n0 + 4 * lane; const size_t ldw = (size_t)j.ldw;
        f32x4 mx = (f32x4){0.f, 0.f, 0.f, 0.f}; f32x4 v[8]; float g[8];
        q8_cm_load(p, ldw, j.gain, j.k0, v, g);
#pragma nounroll
        for (int r = 8; r < 64; r += 8) { f32x4 vn[8]; float gn[8];
            q8_cm_load(p + (size_t)r * ldw, ldw, j.gain, j.k0 + r, vn, gn);
#pragma unroll
            for (int i = 0; i < 8; ++i) { const f32x4 x = v[i] * g[i];
                mx[0] = fmaxf(mx[0], fabsf(x[0])); mx[1] = fmaxf(mx[1], fabsf(x[1])); mx[2] = fmaxf(mx[2], fabsf(x[2])); mx[3] = fmaxf(mx[3], fabsf(x[3])); }
#pragma unroll
            for (int i = 0; i < 8; ++i) { v[i] = vn[i]; g[i] = gn[i]; } }
#pragma unroll
        for (int i = 0; i < 8; ++i) { const f32x4 x = v[i] * g[i];
            mx[0] = fmaxf(mx[0], fabsf(x[0])); mx[1] = fmaxf(mx[1], fabsf(x[1])); mx[2] = fmaxf(mx[2], fabsf(x[2])); mx[3] = fmaxf(mx[3], fabsf(x[3])); }
        unsigned* d = j.smax + drow_l + 4 * (lane & 7);
#pragma unroll
        for (int q = 0; q < 4; ++q) atomicMax(d + q, __float_as_uint(mx[q]));
    }
}
__device__ __forceinline__ void q8_quant(Frame& F, int lo, int hi, int w, int NW) {
    const int lane = F.lane; LAS float* scr = (LAS float*)(F.lds + F.wave * 16384);
    int it = lo + 2 * w; if (it >= hi) return;
    Q8Job cur = q8_job(F, it); f32x4 v[8]; float g[8]; q8_load(cur, v, g, lane);
    u32x4 cmw = *(const u32x4*)(cur.smax + cur.drow0 + 4 * (lane & 7));
    for (;;) {
        const int nx = ((it - lo) & 1) ? it + 2 * NW - 1 : it + 1; const bool more = nx < hi;
        Q8Job nj = cur; f32x4 vn[8]; float gn[8]; u32x4 cmn = cmw;
        if (more) { nj = q8_job(F, nx); q8_load(nj, vn, gn, lane); cmn = *(const u32x4*)(nj.smax + nj.drow0 + 4 * (lane & 7)); }
        f32x4 inv; const float cm[4] = {__uint_as_float(cmw.x), __uint_as_float(cmw.y), __uint_as_float(cmw.z), __uint_as_float(cmw.w)};
#pragma unroll
        for (int q = 0; q < 4; ++q) inv[q] = cm[q] > 0.f ? 127.0f / cm[q] : 0.f;
        if (cur.k0 == 0 && lane < 8) *(f32x4*)(cur.sb + cur.drow0 + 4 * lane) = (f32x4){cm[0], cm[1], cm[2], cm[3]} * (1.0f / 127.0f);
#pragma unroll
        for (int i = 0; i < 8; ++i) { const f32x4 x = v[i] * g[i] * inv;
            LAS float* d = scr + (8 * i + (lane >> 3)) * 33 + 4 * (lane & 7); d[0] = __builtin_rintf(x[0]); d[1] = __builtin_rintf(x[1]); d[2] = __builtin_rintf(x[2]); d[3] = __builtin_rintf(x[3]); }
        LDS_WAIT(); asm volatile("" ::: "memory");
        const int c = lane & 7;
#pragma unroll
        for (int q = 0; q < 4; ++q) { const int n = (lane >> 3) + 8 * q; const LAS float* sp = scr + (8 * c) * 33 + n;
            unsigned b[8];
#pragma unroll
            for (int i = 0; i < 8; ++i) b[i] = (unsigned)(int)sp[i * 33] & 0xffu;
            u32x2 o; o.x = b[0] | (b[1] << 8) | (b[2] << 16) | (b[3] << 24); o.y = b[4] | (b[5] << 8) | (b[6] << 16) | (b[7] << 24);
            *(u32x2*)(cur.WQ + (size_t)(cur.drow0 + n) * D + cur.k0 + 8 * c) = o; }
        LDS_WAIT(); asm volatile("" ::: "memory");
        if (!more) break;
#pragma unroll
        for (int i = 0; i < 8; ++i) { v[i] = vn[i]; g[i] = gn[i]; }
        cmw = cmn; cur = nj; it = nx;
    }
}
__device__ __forceinline__ void quant_row_load(const bf16_t* xrow, u32x4 (&w)[8], int lane) {
#pragma unroll
    for (int j = 0; j < 8; ++j) w[j] = *(const u32x4*)(xrow + (size_t)(j * 64 + lane) * 8);
}
__device__ __forceinline__ void quant_row_finish(const u32x4 (&w)[8], unsigned char* qrow, float* sa, int lane) {
    float mx = 0.f;
#pragma unroll
    for (int j = 0; j < 8; ++j) {
        mx = fmaxf(mx, fmaxf(fmaxf(fabsf(bf_lo(w[j].x)), fabsf(bf_hi(w[j].x))), fmaxf(fabsf(bf_lo(w[j].y)), fabsf(bf_hi(w[j].y)))));
        mx = fmaxf(mx, fmaxf(fmaxf(fabsf(bf_lo(w[j].z)), fabsf(bf_hi(w[j].z))), fmaxf(fabsf(bf_lo(w[j].w)), fabsf(bf_hi(w[j].w))))); }
#pragma unroll
    for (int o = 1; o < 64; o <<= 1) mx = fmaxf(mx, __shfl_xor(mx, o));
    const float inv = mx > 0.f ? 127.0f / mx : 0.f;
#pragma unroll
    for (int j = 0; j < 8; ++j) {
        const unsigned b0 = (unsigned)(int)__builtin_rintf(bf_lo(w[j].x) * inv) & 0xffu, b1 = (unsigned)(int)__builtin_rintf(bf_hi(w[j].x) * inv) & 0xffu, b2 = (unsigned)(int)__builtin_rintf(bf_lo(w[j].y) * inv) & 0xffu, b3 = (unsigned)(int)__builtin_rintf(bf_hi(w[j].y) * inv) & 0xffu;
        const unsigned b4 = (unsigned)(int)__builtin_rintf(bf_lo(w[j].z) * inv) & 0xffu, b5 = (unsigned)(int)__builtin_rintf(bf_hi(w[j].z) * inv) & 0xffu, b6 = (unsigned)(int)__builtin_rintf(bf_lo(w[j].w) * inv) & 0xffu, b7 = (unsigned)(int)__builtin_rintf(bf_hi(w[j].w) * inv) & 0xffu;
        u32x2 o; o.x = b0 | (b1 << 8) | (b2 << 16) | (b3 << 24); o.y = b4 | (b5 << 8) | (b6 << 16) | (b7 << 24);
        *(u32x2*)(qrow + (size_t)(j * 64 + lane) * 8) = o; }
    if (lane == 0) *sa = mx * (1.0f / 127.0f);
}

__device__ __forceinline__ void quant_rows(const bf16_t* X, unsigned char* Q, float* SA, int r0, int r1, int w, int NW, int lane) {
    int r = r0 + w; if (r >= r1) return;
    u32x4 cw[8]; quant_row_load(X + (size_t)r * D, cw, lane);
    for (;;) { const int nx = r + NW; const bool more = nx < r1; u32x4 nw[8];
        if (more) quant_row_load(X + (size_t)nx * D, nw, lane);
        quant_row_finish(cw, Q + (size_t)r * D, SA + r, lane);
        if (!more) break;
#pragma unroll
        for (int j = 0; j < 8; ++j) cw[j] = nw[j];
        r = nx; }
}

__device__ __forceinline__ void p0_prologue(Frame& F) {
    const int gw = F.bid * NWAVES + F.wave, NGW = F.G * NWAVES;
    unsigned char* ws = F.ws;
    convert_items(F, 0, NIT_P0, gw, NGW);
    q8_colmax(F, 0, NIT_Q8, gw, NGW);
    bf16_t* XB = (bf16_t*)(ws + WS_XB); bf16_t* MEMB = (bf16_t*)(ws + WS_MEMB);
    for (int m = gw; m < M + NB * NMEM; m += NGW) {
        if (m < MP) norm_row_to_bf16(F.in[I_XP] + (size_t)m * D, F.in[I_NMIX], XB + (size_t)m * D, F.lane, ws + WS_XBQ + (size_t)m * D, (float*)(ws + WS_SAI) + m);
        else if (m < M) norm_row_to_bf16(F.in[I_XS] + (size_t)(m - MP) * D, F.in[I_NMIX], XB + (size_t)m * D, F.lane, ws + WS_XBQ + (size_t)m * D, (float*)(ws + WS_SAI) + m);
        else norm_row_to_bf16(F.in[I_MEM] + (size_t)(m - M) * D, F.in[I_NMEM], MEMB + (size_t)(m - M) * D, F.lane);
    }
    { const f32x4* src = (const f32x4*)F.in[I_CK]; u32x2* dst = (u32x2*)(ws + WS_MKS); const size_t n4 = (size_t)DECB * NMEM * D / 4;
      for (size_t i = (size_t)F.bid * 512 + F.tid; i < n4; i += (size_t)F.G * 512) { const f32x4 v = src[i]; u32x2 w; w.x = pk2(v.x, v.y); w.y = pk2(v.z, v.w); dst[i] = w; } }
    { const f32x4* src = (const f32x4*)F.in[I_WXQ]; u32x2* dst = (u32x2*)(ws + WS_WXQRM); const float* gx = F.in[I_NXA]; const size_t n4 = (size_t)D * D / 4;
      for (size_t i = (size_t)F.bid * 512 + F.tid; i < n4; i += (size_t)F.G * 512) { const float g = gx[i >> 10]; const f32x4 v = src[i] * g; u32x2 w; w.x = pk2(v.x, v.y); w.y = pk2(v.z, v.w); dst[i] = w; } }
    { float* LB = (float*)(ws + WS_LB); const float* l = F.in[I_LBL];
      for (int i = F.bid * 512 + F.tid; i < HGW; i += F.G * 512) { const float a = l[i], b = l[HGW + i], mx = fmaxf(a, b), ea = expf(a - mx), eb = expf(b - mx); LB[i] = ea / (ea + eb); } }
}

__device__ __forceinline__ void st_bf16x8(bf16_t* p, const f32x4 a, const f32x4 b) { u32x4 w; w.x = cvt_pk_bf16(a[0], a[1]); w.y = cvt_pk_bf16(a[2], a[3]); w.z = cvt_pk_bf16(b[0], b[1]); w.w = cvt_pk_bf16(b[2], b[3]); *(u32x4*)p = w; }

template <int ACT> __device__ __forceinline__ void act8_tiles(const Acc& acc, bf16_t* PROJ, int row0, int col, const float (&rsv)[8], const f32x2 (&sb)[2][4]) {
    const f32x2 c1 = (f32x2){-1.44269504089f, -1.44269504089f}, one = (f32x2){1.0f, 1.0f};
#pragma unroll
    for (int ai = 0; ai < 2; ++ai)
#pragma unroll
        for (int m = 0; m < 4; ++m) { const int row = row0 + ai * 128 + m * 16; const float rf = rsv[ai * 4 + m]; const f32x2 rf2 = (f32x2){rf, rf};
#pragma unroll
            for (int bj = 0; bj < 2; ++bj) { f32x4 o[2];
#pragma unroll
                for (int n = 0; n < 2; ++n) { const i32x4 xi = __builtin_bit_cast(i32x4, acc[ai][bj][m][n]);
#pragma unroll
                    for (int j = 0; j < 4; j += 2) { const f32x2 x = ((f32x2){(float)xi[j], (float)xi[j + 1]} * sb[bj][2 * n + (j >> 1)]) * rf2; f32x2 r = x;
                        if constexpr (ACT != 0) { const f32x2 e = c1 * x; f32x2 t; t.x = fast_exp2(e.x); t.y = fast_exp2(e.y);
                            const f32x2 d = t + one; r.x = fast_rcp(d.x); r.y = fast_rcp(d.y); if constexpr (ACT == 1) r = x * r; }
                        o[n][j] = r.x; o[n][j + 1] = r.y; } }
                st_bf16x8(PROJ + (size_t)row * PW + col + bj * 128, o[0], o[1]); } }
}

struct P1Prob {
    static constexpr bool HAS_MID = false; static constexpr bool I8 = false;
    const char *A, *B, *A2, *B2; unsigned lda, ldb; int nt, G, c;
    bf16_t* PROJ; float* LOGF; const float* LB; float* out; bf16_t* MKB; bf16_t* MVB;
    int nsc, R;
    __device__ __forceinline__ bool next(int i, Unit& u) const {
        long L; constexpr int N0 = 65 * 32;
        if (nsc == 0) L = (long)i * G + c;
        else { const int Gp = G - nsc; if (c >= nsc) L = (i < R) ? (long)i * Gp + (c - nsc) : (long)R * Gp + (long)(i - R) * G + c; else L = (long)R * Gp + (long)i * G + c; }
        if (L < N0) { pg8::static_unit((int)L, 65, 32, u); u.z = 0; return true; }
        if (L < N0 + 64) { const int l = (int)L - N0; u.z = 1; u.pm = l >> 5; u.pn = l & 31; return true; }
        return false;
    }
    __device__ __forceinline__ const char* a_ptr(const Unit& u) const { return (u.z ? A2 : A) + (size_t)u.pm * 256 * lda; }
    __device__ __forceinline__ const char* b_ptr(const Unit& u) const { return (u.z ? B2 : B) + (size_t)u.pn * 256 * ldb; }
    __device__ __forceinline__ void mid(Acc&, const Unit&, int, int, int, int) const {}
    __device__ __forceinline__ void epi(Acc& acc, const Unit& u, int wr, int wc, int fr, int fq, int, int) const {
        const int row0 = u.pm * 256 + wr * 64 + fr, cl = wc * 32 + 8 * fq;
        if (u.z) {
            const bool isv = u.pn >= 16; const int colt = (u.pn & 15) * 256; float* o = out + (isv ? O_MV : O_MK);
#pragma unroll
            for (int ai = 0; ai < 2; ++ai)
#pragma unroll
                for (int m = 0; m < 4; ++m) { const int row = row0 + ai * 128 + m * 16;
#pragma unroll
                    for (int bj = 0; bj < 2; ++bj) { const int col = colt + bj * 128 + cl; const f32x4 v0 = acc[ai][bj][m][0], v1 = acc[ai][bj][m][1];
                        *(f32x4*)(o + (size_t)row * D + col) = v0; *(f32x4*)(o + (size_t)row * D + col + 4) = v1;
                        st_bf16x8((isv ? MVB : MKB) + (size_t)row * D + col, v0, v1); } }
            return;
        }
        const int pn = u.pn;
        if (pn >= 24) {
            const int colt = (pn - 24) * 256;
            f32x4 lb[2][2];
#pragma unroll
            for (int bj = 0; bj < 2; ++bj) { lb[bj][0] = *(const f32x4*)(LB + colt + bj * 128 + cl); lb[bj][1] = *(const f32x4*)(LB + colt + bj * 128 + cl + 4); }
#pragma unroll
            for (int ai = 0; ai < 2; ++ai)
#pragma unroll
                for (int m = 0; m < 4; ++m) { const int row = row0 + ai * 128 + m * 16;
#pragma unroll
                    for (int bj = 0; bj < 2; ++bj)
#pragma unroll
                        for (int n = 0; n < 2; ++n) { f32x4 o;
#pragma unroll
                            for (int j = 0; j < 4; ++j) { const float l = lb[bj][n][j]; o[j] = __log2f(l + (1.0f - l) * sigmoid_f(acc[ai][bj][m][n][j])); }
                            *(f32x4*)(LOGF + (size_t)row * HGW + colt + bj * 128 + cl + 4 * n) = o; } }
            return;
        }
        if (pn < 16) {
            const int colu = PC_U + pn * 128 + cl;
#pragma unroll
            for (int ai = 0; ai < 2; ++ai)
#pragma unroll
                for (int m = 0; m < 4; ++m) { const int row = row0 + ai * 128 + m * 16;
                    const f32x4 u0 = acc[ai][0][m][0] * acc[ai][1][m][0], u1 = acc[ai][0][m][1] * acc[ai][1][m][1];
                    st_bf16x8(PROJ + (size_t)row * PW + colu, u0, u1);
                    int seq, t, L; if (row < MP) { seq = row >> 13; t = row & (SEQ - 1); L = SEQ; } else { seq = (row - MP) >> 5; t = (row - MP) & 31; L = DECS; }
                    if (t >= L - 2) { float* o = (row < MP ? out + O_CP : out + O_CS) + ((size_t)seq * 2 + (t - (L - 2))) * CW + pn * 128 + cl;
                        *(f32x4*)o = u0; *(f32x4*)(o + 4) = u1; } }
            return;
        }
        const int colt = PC_IV + (pn - 16) * 256;
#pragma unroll
        for (int ai = 0; ai < 2; ++ai)
#pragma unroll
            for (int m = 0; m < 4; ++m) { const int row = row0 + ai * 128 + m * 16;
#pragma unroll
                for (int bj = 0; bj < 2; ++bj) st_bf16x8(PROJ + (size_t)row * PW + colt + bj * 128 + cl, acc[ai][bj][m][0], acc[ai][bj][m][1]); }
    }
};

struct GemmBase {
    const char *A, *B; unsigned lda, ldb; int nt, G, c, nM, nN, pm0;
    __device__ __forceinline__ bool next(int i, Unit& u) const { const long L = (long)i * G + c; if (L >= (long)nM * nN) return false; pg8::static_unit((int)L, nM, nN, u); u.pm += pm0; u.z = 0; return true; }
    __device__ __forceinline__ const char* a_ptr(const Unit& u) const { return A + (size_t)u.pm * 256 * lda; }
    __device__ __forceinline__ const char* b_ptr(const Unit& u) const { return B + (size_t)u.pn * 256 * ldb; }
};

struct P1bProb : GemmBase {
    static constexpr bool HAS_MID = false; static constexpr bool I8 = true;
    const float* SA; const float* SB; bf16_t* PROJ; LAS float* rsc; mutable int rsc_pm;
    __device__ __forceinline__ void mid(Acc&, const Unit&, int, int, int, int) const {}
    __device__ __forceinline__ void epi(Acc& acc, const Unit& u, int wr, int wc, int fr, int fq, int, int) const {
        const int row0 = u.pm * 256 + wr * 64 + fr, cl = wc * 32 + 8 * fq, bc0 = u.pn * 256 + cl;
        float rsv[8];
        if (rsc_pm != u.pm) {
#pragma unroll
            for (int q = 0; q < 8; ++q) rsv[q] = SA[row0 + (q >> 2) * 128 + (q & 3) * 16];
            *(LAS f32x4*)rsc = (f32x4){rsv[0], rsv[1], rsv[2], rsv[3]}; *(LAS f32x4*)(rsc + 4) = (f32x4){rsv[4], rsv[5], rsv[6], rsv[7]}; rsc_pm = u.pm;
        } else { const f32x4 a = *(const LAS f32x4*)rsc, b = *(const LAS f32x4*)(rsc + 4); rsv[0] = a[0]; rsv[1] = a[1]; rsv[2] = a[2]; rsv[3] = a[3]; rsv[4] = b[0]; rsv[5] = b[1]; rsv[6] = b[2]; rsv[7] = b[3]; }
        const f32x4 s00 = *(const f32x4*)(SB + bc0), s01 = *(const f32x4*)(SB + bc0 + 4), s10 = *(const f32x4*)(SB + bc0 + 128), s11 = *(const f32x4*)(SB + bc0 + 132);
        const f32x2 sb[2][4] = {{(f32x2){s00[0], s00[1]}, (f32x2){s00[2], s00[3]}, (f32x2){s01[0], s01[1]}, (f32x2){s01[2], s01[3]}}, {(f32x2){s10[0], s10[1]}, (f32x2){s10[2], s10[3]}, (f32x2){s11[0], s11[1]}, (f32x2){s11[2], s11[3]}}};
        const int pn = u.pn;
        if (pn < 8) act8_tiles<0>(acc, PROJ, row0, PC_CB + pn * 256 + cl, rsv, sb);
        else if (pn < 16) act8_tiles<1>(acc, PROJ, row0, PC_OG + (pn - 8) * 256 + cl, rsv, sb);
        else if (pn < 32) act8_tiles<2>(acc, PROJ, row0, PC_GA + (pn - 16) * 256 + cl, rsv, sb);
        else if (pn < 48) act8_tiles<2>(acc, PROJ, row0, PC_GB + (pn - 32) * 256 + cl, rsv, sb);
        else act8_tiles<0>(acc, PROJ, row0, PC_Q + (pn - 48) * 256 + cl, rsv, sb);
    }
};

struct P5Prob : GemmBase {
    static constexpr bool HAS_MID = true; static constexpr bool I8 = false;
    const bf16_t* PROJ; bf16_t* OUT;
    __device__ __forceinline__ void mid(Acc& acc, const Unit& u, int wr, int wc, int, int) const {
        int lz = threadIdx.x & 63; asm volatile("" : "+v"(lz));
        const int fr = lz & 15, fq = lz >> 4;
        const int row0 = u.pm * 256 + wr * 64 + fr, col0 = u.pn * 256 + wc * 32 + 8 * fq;
#pragma unroll
        for (int ai = 0; ai < 2; ++ai) {
#pragma unroll
            for (int m = 0; m < 4; ++m) { const bf16_t* rp = PROJ + (size_t)(row0 + ai * 128 + m * 16) * PW + col0;
#pragma unroll
                for (int bj = 0; bj < 2; ++bj) { const u32x4 ga = *(const u32x4*)(rp + PC_GA + bj * 128), gb = *(const u32x4*)(rp + PC_GB + bj * 128);
                    f32x4 r0, r1;
                    r0[0] = bf_lo(ga.x) * fast_rcp(fmaxf(bf_lo(gb.x), 1e-30f)); r0[1] = bf_hi(ga.x) * fast_rcp(fmaxf(bf_hi(gb.x), 1e-30f)); r0[2] = bf_lo(ga.y) * fast_rcp(fmaxf(bf_lo(gb.y), 1e-30f)); r0[3] = bf_hi(ga.y) * fast_rcp(fmaxf(bf_hi(gb.y), 1e-30f));
                    r1[0] = bf_lo(ga.z) * fast_rcp(fmaxf(bf_lo(gb.z), 1e-30f)); r1[1] = bf_hi(ga.z) * fast_rcp(fmaxf(bf_hi(gb.z), 1e-30f)); r1[2] = bf_lo(ga.w) * fast_rcp(fmaxf(bf_lo(gb.w), 1e-30f)); r1[3] = bf_hi(ga.w) * fast_rcp(fmaxf(bf_hi(gb.w), 1e-30f));
                    acc[ai][bj][m][0] *= r0; acc[ai][bj][m][1] *= r1; }
                if (m & 1) asm volatile("" ::: "memory"); } }
    }
    __device__ __forceinline__ void epi(Acc& acc, const Unit& u, int wr, int wc, int fr, int fq, int, int) const {
        const int row0 = u.pm * 256 + wr * 64 + fr, col0 = u.pn * 256 + wc * 32 + 8 * fq;
#pragma unroll
        for (int ai = 0; ai < 2; ++ai) {
#pragma unroll
            for (int m = 0; m < 4; ++m) { const int row = row0 + ai * 128 + m * 16; const bf16_t* rp = PROJ + (size_t)row * PW + col0;
#pragma unroll
                for (int bj = 0; bj < 2; ++bj) { const u32x4 gb = *(const u32x4*)(rp + PC_GB + bj * 128);
                    f32x4 v0 = acc[ai][bj][m][0], v1 = acc[ai][bj][m][1];
                    v0[0] *= bf_lo(gb.x); v0[1] *= bf_hi(gb.x); v0[2] *= bf_lo(gb.y); v0[3] *= bf_hi(gb.y); v1[0] *= bf_lo(gb.z); v1[1] *= bf_hi(gb.z); v1[2] *= bf_lo(gb.w); v1[3] *= bf_hi(gb.w);
                    st_bf16x8(OUT + (size_t)row * D + col0 + bj * 128, v0, v1); } }
            asm volatile("" ::: "memory"); }
    }
};

template <bool RES_F32, bool Q8 = false> struct ResProb : GemmBase {
    static constexpr bool HAS_MID = false; static constexpr bool I8 = Q8;
    const float* resP; const float* resS;
    bf16_t* XB; float* SS; const float* SA; const float* SB; LAS float* rsc; mutable int rsc_pm;
    __device__ __forceinline__ void mid(Acc&, const Unit&, int, int, int, int) const {}
    __device__ __forceinline__ void epi(Acc& acc, const Unit& u, int wr, int wc, int fr, int fq, int, int) const {
        const int row0 = u.pm * 256 + wr * 64 + fr, col0 = u.pn * 256 + wc * 32 + 8 * fq;
        const float* res = (u.pm < MP / 256) ? resP : resS - (size_t)MP * D;
        float rsv[8]; f32x4 sbv[2][2];
        if constexpr (Q8) {
            if (rsc_pm != u.pm) {
#pragma unroll
                for (int q = 0; q < 8; ++q) rsv[q] = SA[row0 + (q >> 2) * 128 + (q & 3) * 16];
                *(LAS f32x4*)rsc = (f32x4){rsv[0], rsv[1], rsv[2], rsv[3]}; *(LAS f32x4*)(rsc + 4) = (f32x4){rsv[4], rsv[5], rsv[6], rsv[7]}; rsc_pm = u.pm;
            } else { const f32x4 a = *(const LAS f32x4*)rsc, b = *(const LAS f32x4*)(rsc + 4); rsv[0] = a[0]; rsv[1] = a[1]; rsv[2] = a[2]; rsv[3] = a[3]; rsv[4] = b[0]; rsv[5] = b[1]; rsv[6] = b[2]; rsv[7] = b[3]; }
#pragma unroll
            for (int bj = 0; bj < 2; ++bj) { sbv[bj][0] = *(const f32x4*)(SB + col0 + bj * 128); sbv[bj][1] = *(const f32x4*)(SB + col0 + bj * 128 + 4); }
        }
#pragma unroll
        for (int ai = 0; ai < 2; ++ai)
#pragma unroll
            for (int m = 0; m < 4; ++m) { const int row = row0 + ai * 128 + m * 16; float ss = 0.f;
#pragma unroll
                for (int bj = 0; bj < 2; ++bj) { const size_t off = (size_t)row * D + col0 + bj * 128;
                    f32x4 a0, a1;
                    if constexpr (Q8) { const i32x4 i0 = __builtin_bit_cast(i32x4, acc[ai][bj][m][0]), i1 = __builtin_bit_cast(i32x4, acc[ai][bj][m][1]); const float rf = rsv[ai * 4 + m];
                        a0 = (f32x4){(float)i0[0], (float)i0[1], (float)i0[2], (float)i0[3]} * sbv[bj][0] * rf; a1 = (f32x4){(float)i1[0], (float)i1[1], (float)i1[2], (float)i1[3]} * sbv[bj][1] * rf; }
                    else { a0 = acc[ai][bj][m][0]; a1 = acc[ai][bj][m][1]; }
                    f32x4 x0, x1;
                    if constexpr (RES_F32) { x0 = *(const f32x4*)(res + off) + a0; x1 = *(const f32x4*)(res + off + 4) + a1; }
                    else { const u32x4 rw = *(const u32x4*)(XB + off);
                        x0 = (f32x4){bf_lo(rw.x), bf_hi(rw.x), bf_lo(rw.y), bf_hi(rw.y)} + a0; x1 = (f32x4){bf_lo(rw.z), bf_hi(rw.z), bf_lo(rw.w), bf_hi(rw.w)} + a1; }
                    st_bf16x8(XB + off, x0, x1);
                    ss += (x0[0] * x0[0] + x0[1] * x0[1]) + (x0[2] * x0[2] + x0[3] * x0[3]) + (x1[0] * x1[0] + x1[1] * x1[1]) + (x1[2] * x1[2] + x1[3] * x1[3]); }
                ss += __shfl_xor(ss, 16); ss += __shfl_xor(ss, 32);
                if (fq == 0) unsafeAtomicAdd(SS + row, ss);
                if (m == 3) asm volatile("" ::: "memory"); }
    }
};
struct P10sProb : ResProb<false, false> {
    __device__ __forceinline__ const char* b_ptr(const Unit& u) const { return B + ((size_t)(u.pm >> 5) * D + (size_t)u.pn * 256) * ldb; }
};

struct P7Prob : GemmBase {
    static constexpr bool HAS_MID = false; static constexpr bool I8 = true;
    const float* SS; const float* SA; const float* SB; bf16_t* OUT; LAS float* rsc; mutable int rsc_pm;
    __device__ __forceinline__ void mid(Acc&, const Unit&, int, int, int, int) const {}
    __device__ __forceinline__ void epi(Acc& acc, const Unit& u, int wr, int wc, int fr, int fq, int, int) const {
        const int row0 = u.pm * 256 + wr * 64 + fr, col0 = u.pn * 256 + wc * 32 + 8 * fq;
        float rsv[8];
        if (rsc_pm != u.pm) {
#pragma unroll
            for (int q = 0; q < 8; ++q) { const int row = row0 + (q >> 2) * 128 + (q & 3) * 16; rsv[q] = SA[row] * (1.0f / sqrtf(SS[row] * (1.0f / D) + EPS)) * (1.44269504089f / 32.0f); }
            *(LAS f32x4*)rsc = (f32x4){rsv[0], rsv[1], rsv[2], rsv[3]}; *(LAS f32x4*)(rsc + 4) = (f32x4){rsv[4], rsv[5], rsv[6], rsv[7]}; rsc_pm = u.pm;
        } else { const f32x4 a = *(const LAS f32x4*)rsc, b = *(const LAS f32x4*)(rsc + 4); rsv[0] = a[0]; rsv[1] = a[1]; rsv[2] = a[2]; rsv[3] = a[3]; rsv[4] = b[0]; rsv[5] = b[1]; rsv[6] = b[2]; rsv[7] = b[3]; }
        f32x4 sbv[2][2];
#pragma unroll
        for (int bj = 0; bj < 2; ++bj) { sbv[bj][0] = *(const f32x4*)(SB + col0 + bj * 128); sbv[bj][1] = *(const f32x4*)(SB + col0 + bj * 128 + 4); }
#pragma unroll
        for (int ai = 0; ai < 2; ++ai)
#pragma unroll
            for (int m = 0; m < 4; ++m) { const int row = row0 + ai * 128 + m * 16; const float sc = rsv[ai * 4 + m];
#pragma unroll
                for (int bj = 0; bj < 2; ++bj) { const i32x4 i0 = __builtin_bit_cast(i32x4, acc[ai][bj][m][0]), i1 = __builtin_bit_cast(i32x4, acc[ai][bj][m][1]);
                    st_bf16x8(OUT + (size_t)row * D + col0 + bj * 128, (f32x4){(float)i0[0], (float)i0[1], (float)i0[2], (float)i0[3]} * sbv[bj][0] * sc, (f32x4){(float)i1[0], (float)i1[1], (float)i1[2], (float)i1[3]} * sbv[bj][1] * sc); } }
    }
};

struct PreProb {
    static constexpr bool HAS_MID = false; static constexpr bool I8 = false;
    const char *MKB, *MVB, *WXQRM, *WXOT; bf16_t *WPT, *VP; unsigned lda, ldb; int nt, G, c;
    __device__ __forceinline__ void pre(const Unit&, int) const {}
    __device__ __forceinline__ bool next(int i, Unit& u) const { const long L = (long)i * G + c; if (L >= 256) return false; u.z = (int)L >> 7; u.pm = ((int)L & 127) >> 4; u.pn = (int)L & 15; return true; }
    __device__ __forceinline__ const char* a_ptr(const Unit& u) const { const int b = u.pm >> 2, h = u.pm & 3;
        return u.z == 0 ? MKB + (size_t)b * NMEM * lda + (size_t)h * XD * 2 : WXOT + (size_t)u.pn * 256 * lda + (size_t)h * XD * 2; }
    __device__ __forceinline__ const char* b_ptr(const Unit& u) const { const int b = u.pm >> 2, h = u.pm & 3;
        return u.z == 0 ? WXQRM + (size_t)u.pn * 256 * ldb + (size_t)h * XD * 2 : MVB + (size_t)b * NMEM * ldb + (size_t)h * XD * 2; }
    __device__ __forceinline__ void mid(Acc&, const Unit&, int, int, int, int) const {}
    __device__ __forceinline__ void epi(Acc& acc, const Unit& u, int wr, int wc, int fr, int fq, int, int) const {
        const int rl0 = wr * 64 + fr, cl = wc * 32 + 8 * fq, b = u.pm >> 2, h = u.pm & 3;
        bf16_t* base; size_t ld;
        if (u.z == 0) { base = WPT + (size_t)u.pm * NMEM * D + (size_t)u.pn * 256; ld = D; }
        else { base = VP + ((size_t)b * D + (size_t)u.pn * 256) * (XH * NMEM) + (size_t)h * NMEM; ld = XH * NMEM; }
#pragma unroll
        for (int ai = 0; ai < 2; ++ai)
#pragma unroll
            for (int m = 0; m < 4; ++m) { const int rl = rl0 + ai * 128 + m * 16;
#pragma unroll
                for (int bj = 0; bj < 2; ++bj) st_bf16x8(base + (size_t)rl * ld + bj * 128 + cl, acc[ai][bj][m][0], acc[ai][bj][m][1]); }
    }
};

struct P7sProb {
    static constexpr bool HAS_MID = false; static constexpr bool I8 = false;
    const char *X1, *WPT; unsigned lda, ldb; int nt, G, c; const float* SS; bf16_t* PB; LAS float* ldsx;
    __device__ __forceinline__ void pre(const Unit&, int) const {}
    __device__ __forceinline__ bool next(int i, Unit& u) const { const long L = (long)i * G + c; if (L >= 256) return false; u.pm = (int)L >> 2; u.pn = (int)L & 3; u.z = 0; return true; }
    __device__ __forceinline__ const char* a_ptr(const Unit& u) const { return X1 + (size_t)u.pm * 256 * lda; }
    __device__ __forceinline__ const char* b_ptr(const Unit& u) const { return WPT + (size_t)((u.pm >> 5) * 4 + u.pn) * NMEM * ldb; }
    __device__ __forceinline__ void mid(Acc&, const Unit&, int, int, int, int) const {}
    __device__ __forceinline__ void epi(Acc& acc, const Unit& u, int wr, int wc, int fr, int fq, int, int) const {
        const int rl0 = wr * 64 + fr;
#pragma unroll
        for (int ai = 0; ai < 2; ++ai)
#pragma unroll
            for (int m = 0; m < 4; ++m) { const int rl = rl0 + ai * 128 + m * 16; const float sc = (1.0f / sqrtf(SS[u.pm * 256 + rl] * (1.0f / D) + EPS)) * (1.44269504089f / 32.0f);
                float v = -3.0e38f;
#pragma unroll
                for (int bj = 0; bj < 2; ++bj)
#pragma unroll
                    for (int n = 0; n < 2; ++n) { const f32x4 x = acc[ai][bj][m][n] * sc; acc[ai][bj][m][n] = x; v = fmaxf(v, fmaxf(fmaxf(x[0], x[1]), fmaxf(x[2], x[3]))); }
                v = fmaxf(v, __shfl_xor(v, 16)); v = fmaxf(v, __shfl_xor(v, 32));
                if (fq == 0) ldsx[rl * 4 + wc] = v; }
        LDS_WAIT(); __builtin_amdgcn_s_barrier(); asm volatile("" ::: "memory");
#pragma unroll
        for (int ai = 0; ai < 2; ++ai)
#pragma unroll
            for (int m = 0; m < 4; ++m) { const int rl = rl0 + ai * 128 + m * 16; const f32x4 q = *(const LAS f32x4*)(ldsx + rl * 4); const float mx = fmaxf(fmaxf(q[0], q[1]), fmaxf(q[2], q[3])); float sm = 0.f;
#pragma unroll
                for (int bj = 0; bj < 2; ++bj)
#pragma unroll
                    for (int n = 0; n < 2; ++n) { f32x4 p;
#pragma unroll
                        for (int j = 0; j < 4; ++j) p[j] = fast_exp2(acc[ai][bj][m][n][j] - mx);
                        acc[ai][bj][m][n] = p; sm += (p[0] + p[1]) + (p[2] + p[3]); }
                sm += __shfl_xor(sm, 16); sm += __shfl_xor(sm, 32);
                if (fq == 0) ldsx[1024 + rl * 4 + wc] = sm; }
        LDS_WAIT(); __builtin_amdgcn_s_barrier(); asm volatile("" ::: "memory");
        int lz = threadIdx.x & 63; asm volatile("" : "+v"(lz));
        const int rz0 = wr * 64 + (lz & 15), cz = u.pn * NMEM + wc * 32 + 8 * (lz >> 4);
#pragma unroll
        for (int ai = 0; ai < 2; ++ai)
#pragma unroll
            for (int m = 0; m < 4; ++m) { const int rl = rz0 + ai * 128 + m * 16; const f32x4 q = *(const LAS f32x4*)(ldsx + 1024 + rl * 4); const float inv = 1.0f / ((q[0] + q[1]) + (q[2] + q[3]));
#pragma unroll
                for (int bj = 0; bj < 2; ++bj) st_bf16x8(PB + (size_t)(u.pm * 256 + rl) * (XH * NMEM) + cz + bj * 128, acc[ai][bj][m][0] * inv, acc[ai][bj][m][1] * inv); }
        LDS_WAIT(); __builtin_amdgcn_s_barrier(); asm volatile("" ::: "memory");
    }
};

struct P8Prob {
    static constexpr bool HAS_MID = false; static constexpr bool I8 = false;
    const char *QX, *MKB, *MKS; unsigned lda, ldb; int nt, G, c, L0, LN;
    bf16_t* PB; float* LSUM; LAS float* ldsx;
    __device__ __forceinline__ bool next(int i, Unit& u) const { long L = (long)i * G + c; if (L >= LN) return false; L += L0;
        if (L < 256) { u.pm = (int)L >> 2; u.pn = (int)L & 3; u.z = -1; } else { const int l = (int)L - 256; u.pm = 64; u.pn = l & 3; u.z = l >> 2; } return true; }
    __device__ __forceinline__ const char* a_ptr(const Unit& u) const { return QX + (size_t)u.pm * 256 * lda + (size_t)u.pn * XD * 2; }
    __device__ __forceinline__ const char* b_ptr(const Unit& u) const { return (u.z < 0 ? MKB + (size_t)(u.pm >> 5) * NMEM * ldb : MKS + (size_t)u.z * NMEM * ldb) + (size_t)u.pn * XD * 2; }
    __device__ __forceinline__ void mid(Acc&, const Unit&, int, int, int, int) const {}
    __device__ __forceinline__ void epi(Acc& acc, const Unit& u, int wr, int wc, int fr, int fq, int, int) const {
        const int rl0 = wr * 64 + fr;
        float mx[2][4];
#pragma unroll
        for (int ai = 0; ai < 2; ++ai)
#pragma unroll
            for (int m = 0; m < 4; ++m) { float v = -3.0e38f;
#pragma unroll
                for (int bj = 0; bj < 2; ++bj)
#pragma unroll
                    for (int n = 0; n < 2; ++n) { const f32x4 x = acc[ai][bj][m][n]; v = fmaxf(v, fmaxf(fmaxf(x[0], x[1]), fmaxf(x[2], x[3]))); }
                v = fmaxf(v, __shfl_xor(v, 16)); v = fmaxf(v, __shfl_xor(v, 32));
                if (fq == 0) ldsx[(rl0 + ai * 128 + m * 16) * 4 + wc] = v; }
        LDS_WAIT(); __builtin_amdgcn_s_barrier(); asm volatile("" ::: "memory");
#pragma unroll
        for (int ai = 0; ai < 2; ++ai)
#pragma unroll
            for (int m = 0; m < 4; ++m) { const f32x4 q = *(const LAS f32x4*)(ldsx + (rl0 + ai * 128 + m * 16) * 4); mx[ai][m] = fmaxf(fmaxf(q[0], q[1]), fmaxf(q[2], q[3])); }
        LDS_WAIT(); __builtin_amdgcn_s_barrier(); asm volatile("" ::: "memory");
#pragma unroll
        for (int ai = 0; ai < 2; ++ai)
#pragma unroll
            for (int m = 0; m < 4; ++m) { const int rl = rl0 + ai * 128 + m * 16, row = u.pm * 256 + rl; float s = 0.f;
                const bool ok = (u.z < 0) || ((rl >> 5) == u.z);
#pragma unroll
                for (int bj = 0; bj < 2; ++bj) { f32x4 p0, p1;
#pragma unroll
                    for (int j = 0; j < 4; ++j) { p0[j] = fast_exp2(acc[ai][bj][m][0][j] - mx[ai][m]); p1[j] = fast_exp2(acc[ai][bj][m][1][j] - mx[ai][m]); }
                    s += (p0[0] + p0[1]) + (p0[2] + p0[3]) + (p1[0] + p1[1]) + (p1[2] + p1[3]);
                    if (ok) st_bf16x8(PB + (size_t)row * 1024 + u.pn * 256 + bj * 128 + wc * 32 + 8 * fq, p0, p1); }
                s += __shfl_xor(s, 16); s += __shfl_xor(s, 32);
                if (fq == 0 && ok) LSUM[((size_t)row * 4 + u.pn) * 4 + wc] = s; }
    }
};

struct P9Prob {
    static constexpr bool HAS_MID = false; static constexpr bool I8 = false;
    const char *PB, *MVT, *VTS; unsigned lda, ldb; int nt, G, c, L0, LN;
    const float* LSUM; bf16_t* OX; LAS float* rsc; mutable int rsc_key;
    __device__ __forceinline__ bool next(int i, Unit& u) const { long L = (long)i * G + c; if (L >= LN) return false; L += L0;
        if (L < 1024) { const int cc = (int)L & 255, ii = (int)L >> 8; u.pm = cc >> 2; u.pn = (cc & 3) * 4 + ii; u.z = -1; } else { const int l = (int)L - 1024; u.pm = 64; u.pn = l & 15; u.z = l >> 4; } return true; }
    __device__ __forceinline__ const char* a_ptr(const Unit& u) const { return PB + (size_t)u.pm * 256 * lda + (size_t)(u.pn >> 2) * NMEM * 2; }
    __device__ __forceinline__ const char* b_ptr(const Unit& u) const { return (u.z < 0 ? MVT + (size_t)(u.pm >> 5) * D * ldb : VTS + (size_t)u.z * D * ldb) + (size_t)u.pn * 256 * ldb; }
    __device__ __forceinline__ void mid(Acc&, const Unit&, int, int, int, int) const {}
    __device__ __forceinline__ void epi(Acc& acc, const Unit& u, int wr, int wc, int fr, int fq, int, int) const {
        const int rl0 = wr * 64 + fr, col0 = u.pn * 256 + wc * 32 + 8 * fq, h = u.pn >> 2;
        float iv[8]; const int key = u.pm * 4 + h;
        if (rsc_key != key) {
#pragma unroll
            for (int q = 0; q < 8; ++q) { const f32x4 l4 = *(const f32x4*)(LSUM + ((size_t)(u.pm * 256 + rl0 + (q >> 2) * 128 + (q & 3) * 16) * 4 + h) * 4); iv[q] = 1.0f / ((l4[0] + l4[1]) + (l4[2] + l4[3])); }
            *(LAS f32x4*)rsc = (f32x4){iv[0], iv[1], iv[2], iv[3]}; *(LAS f32x4*)(rsc + 4) = (f32x4){iv[4], iv[5], iv[6], iv[7]}; rsc_key = key;
        } else { const f32x4 a = *(const LAS f32x4*)rsc, b = *(const LAS f32x4*)(rsc + 4); iv[0] = a[0]; iv[1] = a[1]; iv[2] = a[2]; iv[3] = a[3]; iv[4] = b[0]; iv[5] = b[1]; iv[6] = b[2]; iv[7] = b[3]; }
#pragma unroll
        for (int ai = 0; ai < 2; ++ai)
#pragma unroll
            for (int m = 0; m < 4; ++m) { const int rl = rl0 + ai * 128 + m * 16, row = u.pm * 256 + rl;
                const bool ok = (u.z < 0) || ((rl >> 5) == u.z);
                if (ok) { const float inv = iv[ai * 4 + m];
#pragma unroll
                    for (int bj = 0; bj < 2; ++bj) st_bf16x8(OX + (size_t)row * D + col0 + bj * 128, acc[ai][bj][m][0] * inv, acc[ai][bj][m][1] * inv); } }
    }
};

struct P11Prob : GemmBase {
    static constexpr bool HAS_MID = false; static constexpr bool I8 = true;
    const float* SS; const float* SA; const float* SB; bf16_t* OUT; int nsc; LAS float* rsc; mutable int rsc_pm;
    __device__ __forceinline__ bool next(int i, Unit& u) const {
        long L;
        if (nsc == 0) L = (long)i * G + c;
        else { if (c < nsc) return false; L = (long)i * (G - nsc) + (c - nsc); }
        if (L >= (long)nM * nN) return false; pg8::static_unit((int)L, nM, nN, u); u.pm += pm0; u.z = 0; return true; }
    __device__ __forceinline__ void mid(Acc&, const Unit&, int, int, int, int) const {}
    __device__ __forceinline__ void epi(Acc& acc, const Unit& u, int wr, int wc, int fr, int fq, int, int) const {
        const int row0 = u.pm * 256 + wr * 64 + fr, col0 = u.pn * 128 + wc * 32 + 8 * fq, bc0 = u.pn * 256 + wc * 32 + 8 * fq;
        float rsv[8];
        if (rsc_pm != u.pm) {
#pragma unroll
            for (int q = 0; q < 8; ++q) { const int row = row0 + (q >> 2) * 128 + (q & 3) * 16; rsv[q] = SA[row] / sqrtf(SS[row] * (1.0f / D) + EPS); }
            *(LAS f32x4*)rsc = (f32x4){rsv[0], rsv[1], rsv[2], rsv[3]}; *(LAS f32x4*)(rsc + 4) = (f32x4){rsv[4], rsv[5], rsv[6], rsv[7]}; rsc_pm = u.pm;
        } else { const f32x4 a = *(const LAS f32x4*)rsc, b = *(const LAS f32x4*)(rsc + 4); rsv[0] = a[0]; rsv[1] = a[1]; rsv[2] = a[2]; rsv[3] = a[3]; rsv[4] = b[0]; rsv[5] = b[1]; rsv[6] = b[2]; rsv[7] = b[3]; }
        const f32x4 sg0 = *(const f32x4*)(SB + bc0), sg1 = *(const f32x4*)(SB + bc0 + 4), su0 = *(const f32x4*)(SB + bc0 + 128), su1 = *(const f32x4*)(SB + bc0 + 132);
        const f32x2 sg[4] = {(f32x2){sg0[0], sg0[1]}, (f32x2){sg0[2], sg0[3]}, (f32x2){sg1[0], sg1[1]}, (f32x2){sg1[2], sg1[3]}};
        const f32x2 su[4] = {(f32x2){su0[0], su0[1]}, (f32x2){su0[2], su0[3]}, (f32x2){su1[0], su1[1]}, (f32x2){su1[2], su1[3]}};
#pragma unroll
        for (int ai = 0; ai < 2; ++ai)
#pragma unroll
            for (int m = 0; m < 4; ++m) { const int row = row0 + ai * 128 + m * 16;
                const float rf = rsv[ai * 4 + m];
                const f32x2 rf2 = (f32x2){rf, rf}, c1 = (f32x2){-1.44269504089f, -1.44269504089f}, one = (f32x2){1.0f, 1.0f};
                f32x4 o[2];
#pragma unroll
                for (int n = 0; n < 2; ++n)
#pragma unroll
                    for (int j = 0; j < 4; j += 2) {
                        const i32x4 gi = __builtin_bit_cast(i32x4, acc[ai][0][m][n]), ui = __builtin_bit_cast(i32x4, acc[ai][1][m][n]);
                        const f32x2 g = ((f32x2){(float)gi[j], (float)gi[j + 1]} * sg[2 * n + (j >> 1)]) * rf2, up = ((f32x2){(float)ui[j], (float)ui[j + 1]} * su[2 * n + (j >> 1)]) * rf2;
                        const f32x2 e = c1 * g; f32x2 t; t.x = fast_exp2(e.x); t.y = fast_exp2(e.y);
                        const f32x2 d = t + one; f32x2 r; r.x = fast_rcp(d.x); r.y = fast_rcp(d.y);
                        const f32x2 q = (g * up) * r; o[n][j] = q.x; o[n][j + 1] = q.y; }
                st_bf16x8(OUT + (size_t)row * FF + col0, o[0], o[1]); }
    }
};

constexpr int VT_LD = 72, KT_LD = 136, BC_LD = 136, OT_LD = 132;
constexpr int L_BC = 0;
constexpr int L_KT = 34816;
constexpr int L_QT = L_KT + 17408;
constexpr int L_VT = L_QT + 17408;
constexpr int L_PT = L_VT + 18432;
constexpr int L_REF = L_PT + 18432;
static_assert(L_REF + 512 <= RING_BYTES, "thin-phase LDS");

struct HItem { int row0, nvalid, h, slot, sidx; };
__device__ __forceinline__ HItem hitem(int item) {
    HItem it; it.slot = item;
    if (item < NSLOT_P) { const int b = item >> 11, c = item & 127; it.h = (item >> 7) & 15; it.row0 = b * SEQ + 64 * c; it.nvalid = 64; it.sidx = -1; }
    else { const int j = item - NSLOT_P; it.sidx = j >> 4; it.h = j & 15; it.row0 = MP + DECS * it.sidx; it.nvalid = DECS; }
    return it;
}
__device__ __forceinline__ void hgrn_load_lg(const float* LOGF, const HItem& it, int ch, int kb, float (&lg)[2][8]) {
#pragma unroll
    for (int j = 0; j < 2; ++j)
#pragma unroll
        for (int i = 0; i < 8; ++i) { const int s = 32 * j + 8 * kb + i; lg[j][i] = (s < it.nvalid) ? LOGF[(size_t)(it.row0 + s) * HGW + it.h * DK + ch] : 0.f; }
}
__device__ __forceinline__ void hgrn_scan(const float (&lg)[2][8], int r, int kb, float (&b)[2][8], float& blast) {
    float T[2];
#pragma unroll
    for (int j = 0; j < 2; ++j) { float a = 0.f;
#pragma unroll
        for (int i = 0; i < 8; ++i) { a += lg[j][i]; b[j][i] = a; } T[j] = a; }
    float t0[4], t1[4];
#pragma unroll
    for (int k = 0; k < 4; ++k) { t0[k] = __shfl(T[0], r + 16 * k); t1[k] = __shfl(T[1], r + 16 * k); }
    float off0 = 0.f, off1 = 0.f;
#pragma unroll
    for (int k = 0; k < 4; ++k) { if (k < kb) { off0 += t0[k]; off1 += t1[k]; } }
    const float tot0 = (t0[0] + t0[1]) + (t0[2] + t0[3]), tot1 = (t1[0] + t1[1]) + (t1[2] + t1[3]);
    off1 += tot0; blast = tot0 + tot1;
#pragma unroll
    for (int i = 0; i < 8; ++i) { b[0][i] += off0; b[1][i] += off1; }
}
__device__ __forceinline__ void hgrn_load_v(const bf16_t* PROJ, const HItem& it, int tid, u32x4 (&vw)[2]) {
#pragma unroll
    for (int q = 0; q < 2; ++q) { const int c = tid + q * 512, s = c >> 4, v0 = (c & 15) * 8;
        vw[q] = (u32x4){0u, 0u, 0u, 0u};
        if (s < it.nvalid) vw[q] = *(const u32x4*)(PROJ + (size_t)(it.row0 + s) * PW + PC_IV + it.h * DV + v0); }
}
__device__ __forceinline__ void hgrn_store_vt(const u32x4 (&vw)[2], LAS bf16_t* VT, int tid) {
#pragma unroll
    for (int q = 0; q < 2; ++q) { const int c = tid + q * 512, s = c >> 4, v0 = (c & 15) * 8; const unsigned ww[4] = {vw[q].x, vw[q].y, vw[q].z, vw[q].w};
#pragma unroll
        for (int i = 0; i < 4; ++i) { VT[(v0 + 2 * i) * VT_LD + s] = (bf16_t)(ww[i] & 0xffffu); VT[(v0 + 2 * i + 1) * VT_LD + s] = (bf16_t)(ww[i] >> 16); } }
}

struct ALoad { float lg[2][8]; u32x4 vw[2]; };
__device__ __forceinline__ void hgrn_a_load(Frame& F, int item, ALoad& L) {
    const HItem it = hitem(item);
    hgrn_load_lg((const float*)(F.ws + WS_LOGF), it, 16 * F.wave + (F.lane & 15), F.lane >> 4, L.lg);
    hgrn_load_v((const bf16_t*)(F.ws + WS_PROJ), it, F.tid, L.vw);
}
__device__ __forceinline__ void hgrn_a_compute(Frame& F, int item, const ALoad& L) {
    const HItem it = hitem(item);
    unsigned char* ws = F.ws;
    float* DEC = (float*)(ws + WS_DEC) + (size_t)it.slot * DK;
    bf16_t* SB16 = (bf16_t*)(ws + WS_ST) + (size_t)it.slot * DK * DV;
    LAS bf16_t* VT = (LAS bf16_t*)(F.lds + L_VT);
    const int w = F.wave, r = F.lane & 15, kb = F.lane >> 4, ch = 16 * w + r;
    float b[2][8], blast;
    hgrn_scan(L.lg, r, kb, b, blast);
    hgrn_store_vt(L.vw, VT, F.tid);
    bf16x8 kf[2];
#pragma unroll
    for (int j = 0; j < 2; ++j) { unsigned pk[4];
#pragma unroll
        for (int i = 0; i < 4; ++i) { const float k0 = (1.0f - fast_exp2(L.lg[j][2 * i])) * fast_exp2(blast - b[j][2 * i]), k1 = (1.0f - fast_exp2(L.lg[j][2 * i + 1])) * fast_exp2(blast - b[j][2 * i + 1]); pk[i] = pk2(k0, k1); }
        kf[j] = __builtin_bit_cast(bf16x8, (u32x4){pk[0], pk[1], pk[2], pk[3]}); }
    if (kb == 0) DEC[ch] = fast_exp2(blast);
    float dk4[4];
#pragma unroll
    for (int i = 0; i < 4; ++i) dk4[i] = fast_exp2(__shfl(blast, 4 * kb + i));
    __syncthreads();
#pragma unroll
    for (int n = 0; n < 8; ++n) { f32x4 acc = (f32x4){0.f, 0.f, 0.f, 0.f};
#pragma unroll
        for (int j = 0; j < 2; ++j) { const bf16x8 vf = *(const LAS bf16x8*)(VT + (16 * n + r) * VT_LD + 32 * j + 8 * kb); acc = __builtin_amdgcn_mfma_f32_16x16x32_bf16(kf[j], vf, acc, 0, 0, 0); }
        const int v = 16 * n + r, k0 = 16 * w + 4 * kb;
        if (it.sidx < 0) { u32x2 dw; dw.x = pk2(acc[0], acc[1]); dw.y = pk2(acc[2], acc[3]); *(u32x2*)(SB16 + (size_t)v * DK + k0) = dw; }
        else { const float* S0 = F.in[I_SH] + ((size_t)it.sidx * NH + it.h) * DK * DV; float* SO = F.out + O_HS + ((size_t)it.sidx * NH + it.h) * DK * DV; f32x4 s0;
#pragma unroll
            for (int i = 0; i < 4; ++i) { s0[i] = S0[(size_t)(k0 + i) * DV + v]; SO[(size_t)(k0 + i) * DV + v] = dk4[i] * s0[i] + acc[i]; }
            u32x2 sw; sw.x = pk2(s0[0], s0[1]); sw.y = pk2(s0[2], s0[3]); *(u32x2*)(SB16 + (size_t)v * DK + k0) = sw; } }
    __syncthreads();
}

__device__ __forceinline__ void conv_item(Frame& F, int item) {
    bf16_t* PROJ = (bf16_t*)(F.ws + WS_PROJ); const float* cw = F.in[I_CONVW];
    const int cchunk = F.tid & 255, half = F.tid >> 8, c0 = cchunk * 8, rbeg = item * 64 + half * 32;
    float w0[8], w1[8], w2[8];
#pragma unroll
    for (int i = 0; i < 8; ++i) { w0[i] = cw[c0 + i]; w1[i] = cw[CW + c0 + i]; w2[i] = cw[2 * CW + c0 + i]; }
    float um2[8], um1[8];
    bool seq_start; const float* cbuf = nullptr;
    if (rbeg < MP) seq_start = (rbeg & (SEQ - 1)) == 0; else { seq_start = true; cbuf = F.in[I_SC] + (size_t)((rbeg - MP) >> 5) * 2 * CW; }
    if (seq_start) {
#pragma unroll
        for (int i = 0; i < 8; ++i) { um2[i] = cbuf ? cbuf[c0 + i] : 0.f; um1[i] = cbuf ? cbuf[CW + c0 + i] : 0.f; }
    } else { const u32x4 a = *(const u32x4*)(PROJ + (size_t)(rbeg - 2) * PW + PC_U + c0), b = *(const u32x4*)(PROJ + (size_t)(rbeg - 1) * PW + PC_U + c0);
        um2[0] = bf_lo(a.x); um2[1] = bf_hi(a.x); um2[2] = bf_lo(a.y); um2[3] = bf_hi(a.y); um2[4] = bf_lo(a.z); um2[5] = bf_hi(a.z); um2[6] = bf_lo(a.w); um2[7] = bf_hi(a.w);
        um1[0] = bf_lo(b.x); um1[1] = bf_hi(b.x); um1[2] = bf_lo(b.y); um1[3] = bf_hi(b.y); um1[4] = bf_lo(b.z); um1[5] = bf_hi(b.z); um1[6] = bf_lo(b.w); um1[7] = bf_hi(b.w); }
#pragma unroll 4
    for (int t = 0; t < 32; ++t) { const size_t ro = (size_t)(rbeg + t) * PW;
        const u32x4 uu = *(const u32x4*)(PROJ + ro + PC_U + c0), cb = *(const u32x4*)(PROJ + ro + PC_CB + c0);
        float u[8], c[8];
        u[0] = bf_lo(uu.x); u[1] = bf_hi(uu.x); u[2] = bf_lo(uu.y); u[3] = bf_hi(uu.y); u[4] = bf_lo(uu.z); u[5] = bf_hi(uu.z); u[6] = bf_lo(uu.w); u[7] = bf_hi(uu.w);
        c[0] = bf_lo(cb.x); c[1] = bf_hi(cb.x); c[2] = bf_lo(cb.y); c[3] = bf_hi(cb.y); c[4] = bf_lo(cb.z); c[5] = bf_hi(cb.z); c[6] = bf_lo(cb.w); c[7] = bf_hi(cb.w);
        float o[8];
#pragma unroll
        for (int i = 0; i < 8; ++i) { o[i] = c[i] * (w0[i] * um2[i] + w1[i] * um1[i] + w2[i] * u[i]); um2[i] = um1[i]; um1[i] = u[i]; }
        u32x4 ow; ow.x = pk2(o[0], o[1]); ow.y = pk2(o[2], o[3]); ow.z = pk2(o[4], o[5]); ow.w = pk2(o[6], o[7]);
        *(u32x4*)(PROJ + ro + PC_CB + c0) = ow; }
}

__device__ __forceinline__ void hgrn_b(Frame& F) {
    const float* DEC = (const float*)(F.ws + WS_DEC); bf16_t* SB16 = (bf16_t*)(F.ws + WS_ST);
    for (int g = F.bid * 512 + F.tid; g < NB * NH * (DK * DV / 4); g += F.G * 512) {
        const int bh = g >> 12, e4 = g & 4095, v = e4 >> 5, k0 = (e4 & 31) * 4;
        u32x2* sp = (u32x2*)(SB16 + (size_t)bh * NCHUNK * DK * DV + (size_t)v * DK + k0); const f32x4* dp = (const f32x4*)(DEC + (size_t)bh * NCHUNK * DK + k0);
        f32x4 s = (f32x4){0.f, 0.f, 0.f, 0.f};
        for (int c0 = 0; c0 < NCHUNK; c0 += 16) { u32x2 t[16]; f32x4 d[16];
#pragma unroll
            for (int i = 0; i < 16; ++i) { t[i] = sp[(size_t)(c0 + i) * (DK * DV / 4)]; d[i] = dp[(size_t)(c0 + i) * (DK / 4)]; }
#pragma unroll
            for (int i = 0; i < 16; ++i) { u32x2 sw; sw.x = pk2(s[0], s[1]); sw.y = pk2(s[2], s[3]); sp[(size_t)(c0 + i) * (DK * DV / 4)] = sw;
                s = d[i] * s + (f32x4){bf_lo(t[i].x), bf_hi(t[i].x), bf_lo(t[i].y), bf_hi(t[i].y)}; } }
        float* o = F.out + O_HP + (size_t)bh * DK * DV;
#pragma unroll
        for (int i = 0; i < 4; ++i) o[(size_t)(k0 + i) * DV + v] = s[i];
    }
}

struct CLoad { float lg[2][8]; u32x4 qw[2], vw[2], ogw[2], st[4]; };
__device__ __forceinline__ void hgrn_c_load(Frame& F, int item, CLoad& L) {
    const HItem it = hitem(item); const int tid = F.tid;
    const bf16_t* PROJ = (const bf16_t*)(F.ws + WS_PROJ); const bf16_t* SB16 = (const bf16_t*)(F.ws + WS_ST) + (size_t)it.slot * DK * DV;
#pragma unroll
    for (int j = 0; j < 4; ++j) L.st[j] = *(const u32x4*)(SB16 + (size_t)(tid + 512 * j) * 8);
#pragma unroll
    for (int q = 0; q < 2; ++q) { const int c = tid + q * 512, t = c >> 4, k0 = (c & 15) * 8; L.qw[q] = (u32x4){0u, 0u, 0u, 0u}; L.vw[q] = L.qw[q]; L.ogw[q] = L.qw[q];
        if (t < it.nvalid) { const bf16_t* rp = PROJ + (size_t)(it.row0 + t) * PW + it.h * DK + k0; L.qw[q] = *(const u32x4*)(rp + PC_Q); L.vw[q] = *(const u32x4*)(rp + PC_IV); L.ogw[q] = *(const u32x4*)(rp + PC_OG); } }
    hgrn_load_lg((const float*)(F.ws + WS_LOGF), it, 16 * F.wave + (F.lane & 15), F.lane >> 4, L.lg);
}
__device__ __forceinline__ void hgrn_c_compute(Frame& F, int item, const CLoad& L) {
    const HItem it = hitem(item);
    unsigned char* ws = F.ws; bf16_t* PROJ = (bf16_t*)(ws + WS_PROJ);
    LAS float* BC = (LAS float*)(F.lds + L_BC); LAS bf16_t* SL = (LAS bf16_t*)(F.lds + L_BC); LAS bf16_t* KT = (LAS bf16_t*)(F.lds + L_KT); LAS bf16_t* QT = (LAS bf16_t*)(F.lds + L_QT);
    LAS float* OT = (LAS float*)(F.lds + L_KT);
    LAS bf16_t* VT = (LAS bf16_t*)(F.lds + L_VT); LAS bf16_t* PT = (LAS bf16_t*)(F.lds + L_PT) + F.wave * 16 * VT_LD; LAS float* REF = (LAS float*)(F.lds + L_REF);
    const int w = F.wave, r = F.lane & 15, kb = F.lane >> 4, tid = F.tid;
    {
        const int ch = 16 * w + r;
        float b[2][8], blast;
        hgrn_scan(L.lg, r, kb, b, blast);
        const float ref = __shfl(b[0][7], r + 48);
#pragma unroll
        for (int j = 0; j < 2; ++j)
#pragma unroll
            for (int i = 0; i < 8; ++i) { const int s = 32 * j + 8 * kb + i; BC[s * BC_LD + ch] = b[j][i];
                KT[s * KT_LD + ch] = (bf16_t)f2bf((1.0f - fast_exp2(L.lg[j][i])) * fast_exp2(ref - b[j][i])); }
        if (kb == 0) REF[ch] = ref;
#pragma unroll
        for (int q = 0; q < 2; ++q) { const int c = tid + q * 512, s = c >> 4, v0 = (c & 15) * 8; const unsigned ww[4] = {L.vw[q].x, L.vw[q].y, L.vw[q].z, L.vw[q].w};
#pragma unroll
            for (int i = 0; i < 4; ++i) { VT[(v0 + 2 * i) * VT_LD + s] = (bf16_t)(ww[i] & 0xffffu); VT[(v0 + 2 * i + 1) * VT_LD + s] = (bf16_t)(ww[i] >> 16); } }
    }
    __syncthreads();
    {
#pragma unroll
        for (int q = 0; q < 2; ++q) { const int c = tid + q * 512, t = c >> 4, k0 = (c & 15) * 8;
            const f32x4 b0 = *(const LAS f32x4*)(BC + t * BC_LD + k0), b1 = *(const LAS f32x4*)(BC + t * BC_LD + k0 + 4), r0 = *(const LAS f32x4*)(REF + k0), r1 = *(const LAS f32x4*)(REF + k0 + 4);
            u32x4 o;
            o.x = pk2(bf_lo(L.qw[q].x) * fast_exp2(b0[0] - r0[0]), bf_hi(L.qw[q].x) * fast_exp2(b0[1] - r0[1])); o.y = pk2(bf_lo(L.qw[q].y) * fast_exp2(b0[2] - r0[2]), bf_hi(L.qw[q].y) * fast_exp2(b0[3] - r0[3]));
            o.z = pk2(bf_lo(L.qw[q].z) * fast_exp2(b1[0] - r1[0]), bf_hi(L.qw[q].z) * fast_exp2(b1[1] - r1[1])); o.w = pk2(bf_lo(L.qw[q].w) * fast_exp2(b1[2] - r1[2]), bf_hi(L.qw[q].w) * fast_exp2(b1[3] - r1[3]));
            *(LAS u32x4*)(QT + t * KT_LD + k0) = o; }
    }
    __syncthreads();
    {
#pragma unroll
        for (int j = 0; j < 4; ++j) { const int e = tid + 512 * j, v = e >> 4, k8 = (e & 15) * 8; const f32x4 r0 = *(const LAS f32x4*)(REF + k8), r1 = *(const LAS f32x4*)(REF + k8 + 4);
            u32x4 o; o.x = pk2(bf_lo(L.st[j].x) * fast_exp2(r0[0]), bf_hi(L.st[j].x) * fast_exp2(r0[1])); o.y = pk2(bf_lo(L.st[j].y) * fast_exp2(r0[2]), bf_hi(L.st[j].y) * fast_exp2(r0[3]));
            o.z = pk2(bf_lo(L.st[j].z) * fast_exp2(r1[0]), bf_hi(L.st[j].z) * fast_exp2(r1[1])); o.w = pk2(bf_lo(L.st[j].w) * fast_exp2(r1[2]), bf_hi(L.st[j].w) * fast_exp2(r1[3]));
            *(LAS u32x4*)(SL + v * KT_LD + k8) = o; }
    }
    const int tb = w & 3, vh = w >> 2;
    bf16x8 af[4], pf[2];
    {
#pragma unroll
        for (int kc = 0; kc < 4; ++kc) af[kc] = *(const LAS bf16x8*)(QT + (16 * tb + r) * KT_LD + 32 * kc + 8 * kb);
#pragma unroll
        for (int sb = 0; sb < 4; ++sb) { f32x4 p = (f32x4){0.f, 0.f, 0.f, 0.f};
            if (sb <= tb) {
#pragma unroll
                for (int kc = 0; kc < 4; ++kc) { const bf16x8 kf = *(const LAS bf16x8*)(KT + (16 * sb + r) * KT_LD + 32 * kc + 8 * kb); p = __builtin_amdgcn_mfma_f32_16x16x32_bf16(af[kc], kf, p, 0, 0, 0); } }
#pragma unroll
            for (int i = 0; i < 4; ++i) { const bool keep = (sb < tb) || (sb == tb && r <= 4 * kb + i); PT[(4 * kb + i) * VT_LD + 16 * sb + r] = (bf16_t)f2bf(keep ? p[i] : 0.f); } }
        LDS_WAIT(); asm volatile("" ::: "memory");
#pragma unroll
        for (int j = 0; j < 2; ++j) pf[j] = *(const LAS bf16x8*)(PT + r * VT_LD + 32 * j + 8 * kb);
    }
    __syncthreads();
    {
#pragma unroll
        for (int n = 0; n < 4; ++n) { const int v = 64 * vh + 16 * n + r; f32x4 acc = (f32x4){0.f, 0.f, 0.f, 0.f};
#pragma unroll
            for (int kc = 0; kc < 4; ++kc) { const bf16x8 sf = *(const LAS bf16x8*)(SL + v * KT_LD + 32 * kc + 8 * kb); acc = __builtin_amdgcn_mfma_f32_16x16x32_bf16(af[kc], sf, acc, 0, 0, 0); }
#pragma unroll
            for (int j = 0; j < 2; ++j) { const bf16x8 vf = *(const LAS bf16x8*)(VT + v * VT_LD + 32 * j + 8 * kb); acc = __builtin_amdgcn_mfma_f32_16x16x32_bf16(pf[j], vf, acc, 0, 0, 0); }
#pragma unroll
            for (int i = 0; i < 4; ++i) OT[(16 * tb + 4 * kb + i) * OT_LD + v] = acc[i]; }
    }
    __syncthreads();
    {
        const float* hg = F.in[I_HGN] + it.h * DV;
#pragma unroll
        for (int q = 0; q < 2; ++q) { const int c = tid + q * 512, t = c >> 4, v0 = (c & 15) * 8;
            const f32x4 o0 = *(const LAS f32x4*)(OT + t * OT_LD + v0), o1 = *(const LAS f32x4*)(OT + t * OT_LD + v0 + 4);
            float ss = (o0[0] * o0[0] + o0[1] * o0[1]) + (o0[2] * o0[2] + o0[3] * o0[3]) + (o1[0] * o1[0] + o1[1] * o1[1]) + (o1[2] * o1[2] + o1[3] * o1[3]);
            ss += __shfl_xor(ss, 1); ss += __shfl_xor(ss, 2); ss += __shfl_xor(ss, 4); ss += __shfl_xor(ss, 8);
            const float rs = 1.0f / sqrtf(ss * (1.0f / DV) + EPS);
            if (t < it.nvalid) { const size_t ro = (size_t)(it.row0 + t) * PW + it.h * DV + v0;
                const u32x4 og = L.ogw[q]; const f32x4 g0 = *(const f32x4*)(hg + v0), g1 = *(const f32x4*)(hg + v0 + 4);
                u32x4 ow;
                ow.x = pk2(o0[0] * rs * g0[0] * bf_lo(og.x), o0[1] * rs * g0[1] * bf_hi(og.x)); ow.y = pk2(o0[2] * rs * g0[2] * bf_lo(og.y), o0[3] * rs * g0[3] * bf_hi(og.y));
                ow.z = pk2(o1[0] * rs * g1[0] * bf_lo(og.z), o1[1] * rs * g1[1] * bf_hi(og.z)); ow.w = pk2(o1[2] * rs * g1[2] * bf_lo(og.w), o1[3] * rs * g1[3] * bf_hi(og.w));
                *(u32x4*)(PROJ + ro + PC_Q) = ow; } }
    }
    __syncthreads();
}

__device__ __forceinline__ void final_norm(Frame& F) {
    const float* SS = (const float*)(F.ws + WS_SS3); const f32x4* g4 = (const f32x4*)F.in[I_NFIN]; const bf16_t* X3 = (const bf16_t*)(F.ws + WS_X1B);
    const f32x4 ga = g4[2 * F.tid], gb = g4[2 * F.tid + 1];
    for (int row = F.bid; row < M; row += 4 * F.G) { u32x4 xw[4]; float ssv[4];
#pragma unroll
        for (int q = 0; q < 4; ++q) { const int rw = row + q * F.G; if (rw < M) { xw[q] = *(const u32x4*)(X3 + (size_t)rw * D + 8 * F.tid); ssv[q] = SS[rw]; } }
#pragma unroll
        for (int q = 0; q < 4; ++q) { const int rw = row + q * F.G; if (rw < M) { const float rs = 1.0f / sqrtf(ssv[q] * (1.0f / D) + EPS);
            f32x4* y = (f32x4*)(F.out + O_Y + (size_t)rw * D) + 2 * F.tid;
            y[0] = (f32x4){bf_lo(xw[q].x), bf_hi(xw[q].x), bf_lo(xw[q].y), bf_hi(xw[q].y)} * rs * ga; y[1] = (f32x4){bf_lo(xw[q].z), bf_hi(xw[q].z), bf_lo(xw[q].w), bf_hi(xw[q].w)} * rs * gb; } } }
}

constexpr int N_PHASES = 14;
__global__ void __launch_bounds__(NWAVES * 64, 2) mk_fwd(Args args) {
    extern __shared__ __attribute__((aligned(16))) unsigned char lds_raw[];
    Frame F;
    F.lds = (LAS unsigned char*)lds_raw;
    F.tid = threadIdx.x; F.lane = F.tid & 63; F.wave = __builtin_amdgcn_readfirstlane(F.tid >> 6);
    F.G = gridDim.x; F.bid = blockIdx.x;
    F.in = args.in; F.out = args.out; F.ws = args.ws;
    volatile LAS unsigned* MISC = (volatile LAS unsigned*)(F.lds + MISC_OFF);
    if (F.tid < 64) MISC[F.tid] = 0u;
    __syncthreads();
    unsigned* ctl = (unsigned*)(args.ws + WS_CTL);
    XcdBarrier bar; bar.bar = ctl + CW_BAR; bar.x = 0; bar.st = nullptr;
#if MK_ONE_LAUNCH
    bar = xcd_barrier_post(ctl + CW_BAR, MISC + 8);
#endif
    const int lo = args.ph_lo, hi = args.ph_hi;
#ifndef PH_MASK
#define PH_MASK 0xffff
#endif
#define IN(k) (((PH_MASK >> (k)) & 1) && lo <= (k) && (k) < hi)
#define SEAM(k) do { if (IN(k) && IN((k) + 1)) xcd_barrier(bar); } while (0)
    unsigned char* ws = args.ws;
#define PHASE_WS() do { unsigned char* _w = args.ws; asm volatile("" : "+s"(_w)); F.ws = _w; ws = _w; } while (0)
    const int G = F.G, c = F.bid;

    if (IN(0)) { PHASE_WS(); p0_prologue(F); xcd_barrier(bar); q8_quant(F, 0, NIT_Q8, c * NWAVES + F.wave, G * NWAVES); } SEAM(0);

    if (IN(1)) { PHASE_WS();
        P1Prob P; P.A = (const char*)(ws + WS_XB); P.B = (const char*)(ws + WS_WIN + (size_t)2048 * D * 2); P.A2 = (const char*)(ws + WS_MEMB); P.B2 = (const char*)(ws + WS_WKV);
        P.lda = D * 2; P.ldb = D * 2; P.nt = D / 64; P.G = G; P.c = c;
        P.PROJ = (bf16_t*)(ws + WS_PROJ); P.LOGF = (float*)(ws + WS_LOGF); P.LB = (const float*)(ws + WS_LB); P.out = F.out; P.MKB = (bf16_t*)(ws + WS_MKB); P.MVB = (bf16_t*)(ws + WS_MVB);
        P.nsc = 0; P.R = 0;
        pg8::gemm_phase(F.lds, P);
        constexpr int P1_UNITS = 65 * 32 + 64;
        const int rounds = (P1_UNITS + G - 1) / G, busy = P1_UNITS - (rounds - 1) * G;
        if (busy < G) { if (c >= busy) convert_items(F, NIT_P0, NIT_W, (c - busy) * NWAVES + F.wave, (G - busy) * NWAVES); }
        else convert_items(F, NIT_P0, NIT_W, c * NWAVES + F.wave, G * NWAVES);
        __syncthreads();
        P1bProb Q; Q.A = (const char*)(ws + WS_XBQ); Q.B = (const char*)(ws + WS_WIN8); Q.lda = D; Q.ldb = D; Q.nt = D / 128; Q.G = G; Q.c = c; Q.nM = M / 256; Q.nN = 56; Q.pm0 = 0;
        Q.SA = (const float*)(ws + WS_SAI); Q.SB = (const float*)(ws + WS_SBI); Q.PROJ = (bf16_t*)(ws + WS_PROJ); Q.rsc = (LAS float*)(F.lds + RSC_OFF) + F.tid * 8; Q.rsc_pm = -1;
        pg8::gemm_phase(F.lds, Q);
    } SEAM(1);

    if (IN(2)) { PHASE_WS();
        {
            PreProb R; R.MKB = (const char*)(ws + WS_MKB); R.MVB = (const char*)(ws + WS_MVB); R.WXQRM = (const char*)(ws + WS_WXQRM); R.WXOT = (const char*)(ws + WS_WXOT);
            R.WPT = (bf16_t*)(ws + WS_WPT); R.VP = (bf16_t*)(ws + WS_VP); R.lda = D * 2; R.ldb = D * 2; R.nt = XD / 64; R.G = G; R.c = c;
            pg8::gemm_phase(F.lds, R);
        }
        int it = c;
        if (it < NSLOT) { ALoad cur; hgrn_a_load(F, it, cur);
            for (;;) { const int nx = it + G; const bool more = nx < NSLOT; ALoad nl = cur; if (more) hgrn_a_load(F, nx, nl);
                hgrn_a_compute(F, it, cur); it = nx; if (!more) break; cur = nl; } }
        for (; it < NSLOT + M / 64; it += G) conv_item(F, it - NSLOT);
    } SEAM(2);
    if (IN(3)) { PHASE_WS(); hgrn_b(F); } SEAM(3);
    if (IN(4)) { PHASE_WS();
        int it = c;
        if (it < NSLOT) { CLoad cur; hgrn_c_load(F, it, cur);
            for (;;) { const int nx = it + G; const bool more = nx < NSLOT; CLoad nl = cur; if (more) hgrn_c_load(F, nx, nl);
                hgrn_c_compute(F, it, cur); if (!more) break; it = nx; cur = nl; } }
    } SEAM(4);

#define SETUP_P5(P, nM_, pm0_, G_, c_) P5Prob P; P.A = (const char*)(ws + WS_PROJ); P.B = (const char*)(ws + WS_WAB); P.lda = PW * 2; P.ldb = D * 2; P.nt = D / 64; P.G = G_; P.c = c_; P.nM = nM_; P.nN = D / 256; P.pm0 = pm0_; \
        P.PROJ = (const bf16_t*)(ws + WS_PROJ); P.OUT = (bf16_t*)(ws + WS_MERGED)
#define SETUP_P6(P, nM_, pm0_, G_, c_) ResProb<true> P; P.A = (const char*)(ws + WS_MERGED); P.B = (const char*)(ws + WS_WO); P.lda = D * 2; P.ldb = D * 2; P.nt = D / 64; P.G = G_; P.c = c_; P.nM = nM_; P.nN = D / 256; P.pm0 = pm0_; \
        P.resP = F.in[I_XP]; P.resS = F.in[I_XS]; P.XB = (bf16_t*)(ws + WS_X1B); P.SS = (float*)(ws + WS_SS1); P.SA = nullptr; P.SB = nullptr; P.rsc = nullptr; P.rsc_pm = -1
#define SETUP_P7(P, nM_, pm0_, G_, c_) P7Prob P; P.A = (const char*)((unsigned char*)F.out + DO_X1Q); P.B = (const char*)(ws + WS_WXQ); P.lda = D; P.ldb = D; P.nt = D / 128; P.G = G_; P.c = c_; P.nM = nM_; P.nN = D / 256; P.pm0 = pm0_; \
        P.SS = (const float*)(ws + WS_SS1); P.SA = (const float*)(ws + WS_SA1); P.SB = (const float*)(ws + WS_SBQ); P.OUT = (bf16_t*)(ws + WS_QX); P.rsc = (LAS float*)(F.lds + RSC_OFF) + F.tid * 8; P.rsc_pm = -1
#define SETUP_P8(P, L0_, LN_, G_, c_) P8Prob P; P.QX = (const char*)(ws + WS_QX); P.MKB = (const char*)(ws + WS_MKB); P.MKS = (const char*)(ws + WS_MKS); P.lda = D * 2; P.ldb = D * 2; P.nt = XD / 64; P.G = G_; P.c = c_; P.L0 = L0_; P.LN = LN_; \
        P.PB = (bf16_t*)(ws + WS_PB); P.LSUM = (float*)(ws + WS_LSUM); P.ldsx = (LAS float*)(F.lds + LDSX_OFF)
#define SETUP_P9(P, L0_, LN_, G_, c_) P9Prob P; P.PB = (const char*)(ws + WS_PB); P.MVT = (const char*)(ws + WS_VTS); P.VTS = (const char*)(ws + WS_VTS); P.lda = 1024 * 2; P.ldb = NMEM * 2; P.nt = NMEM / 64; P.G = G_; P.c = c_; P.L0 = L0_; P.LN = LN_; P.rsc = (LAS float*)(F.lds + RSC_OFF) + F.tid * 8; P.rsc_key = -1; \
        P.LSUM = (const float*)(ws + WS_LSUM); P.OX = (bf16_t*)(ws + WS_OX)
#define SETUP_P10(P, nM_, pm0_, G_, c_) ResProb<false> P; P.A = (const char*)(ws + WS_OX); P.B = (const char*)(ws + WS_WXOT); P.lda = D * 2; P.ldb = D * 2; P.nt = D / 64; P.G = G_; P.c = c_; P.nM = nM_; P.nN = D / 256; P.pm0 = pm0_; \
        P.resP = nullptr; P.resS = nullptr; P.XB = (bf16_t*)(ws + WS_X1B); P.SS = (float*)(ws + WS_SS2); P.SA = nullptr; P.SB = nullptr; P.rsc = nullptr; P.rsc_pm = -1
#define SETUP_P11(P, nM_, pm0_, G_, c_, nsc_) P11Prob P; P.A = (const char*)(ws + WS_X2Q); P.B = (const char*)(ws + WS_WGU); P.lda = D; P.ldb = D; P.nt = D / 128; P.G = G_; P.c = c_; P.nM = nM_; P.nN = 2 * FF / 256; P.pm0 = pm0_; P.nsc = nsc_; P.rsc = (LAS float*)(F.lds + RSC_OFF) + F.tid * 8; P.rsc_pm = -1; \
        P.SS = (const float*)(ws + WS_SS2); P.SA = (const float*)(ws + WS_SA); P.SB = (const float*)(ws + WS_SB); P.OUT = (bf16_t*)(ws + WS_GU)
#define SETUP_P12(P, nM_, pm0_, G_, c_) ResProb<false> P; P.A = (const char*)(ws + WS_GU); P.B = (const char*)(ws + WS_WD); P.lda = FF * 2; P.ldb = FF * 2; P.nt = FF / 64; P.G = G_; P.c = c_; P.nM = nM_; P.nN = D / 256; P.pm0 = pm0_; \
        P.resP = nullptr; P.resS = nullptr; P.XB = (bf16_t*)(ws + WS_X1B); P.SS = (float*)(ws + WS_SS3); P.SA = nullptr; P.SB = nullptr; P.rsc = nullptr; P.rsc_pm = -1
    constexpr int NPP = MP / 256;
    const int nsc = (G >= 64) ? NSC : 0;

    if (IN(5)) { PHASE_WS(); SETUP_P5(P, NPP, 0, G, c); pg8::gemm_phase(F.lds, P); } SEAM(5);
    if (IN(6)) { PHASE_WS(); SETUP_P6(P, NPP, 0, G, c); pg8::gemm_phase(F.lds, P); } SEAM(6);
    if (IN(7)) {
        PHASE_WS();
        P7sProb P; P.X1 = (const char*)(ws + WS_X1B); P.WPT = (const char*)(ws + WS_WPT); P.lda = D * 2; P.ldb = D * 2; P.nt = D / 64; P.G = G; P.c = c;
        P.SS = (const float*)(ws + WS_SS1); P.PB = (bf16_t*)(ws + WS_PB); P.ldsx = (LAS float*)(F.lds + LDSX_OFF);
        pg8::gemm_phase(F.lds, P);
    } SEAM(7);
    if (IN(10)) {
        PHASE_WS();
        P10sProb P; P.A = (const char*)(ws + WS_PB); P.B = (const char*)(ws + WS_VP); P.lda = XH * NMEM * 2; P.ldb = XH * NMEM * 2; P.nt = XH * NMEM / 64; P.G = G; P.c = c; P.nM = NPP; P.nN = D / 256; P.pm0 = 0;
        P.resP = nullptr; P.resS = nullptr; P.XB = (bf16_t*)(ws + WS_X1B); P.SS = (float*)(ws + WS_SS2); P.SA = nullptr; P.SB = nullptr; P.rsc = nullptr; P.rsc_pm = -1;
        pg8::gemm_phase(F.lds, P);
    } SEAM(10);
    if (IN(11)) { PHASE_WS();
        {
            const bf16_t* X2 = (const bf16_t*)(ws + WS_X1B); unsigned char* XQ = ws + WS_X2Q; float* SAp = (float*)(ws + WS_SA);
            quant_rows(X2, XQ, SAp, 0, MP, c * NWAVES + F.wave, G * NWAVES, F.lane);
            xcd_barrier(bar);
        }
        const int Gs = nsc ? nsc : G;
        if (c < Gs) {
            unsigned* sbw = ctl + CW_SUB; unsigned* tmo = ctl + CW_BAR + XB_TMO; unsigned gen = 0;
            { SETUP_P5(S, 1, NPP, Gs, c); pg8::gemm_phase(F.lds, S); } sub_barrier(sbw, Gs, gen, tmo);
            { SETUP_P6(S, 1, NPP, Gs, c); pg8::gemm_phase(F.lds, S); } sub_barrier(sbw, Gs, gen, tmo);
            quant_rows((const bf16_t*)(ws + WS_X1B), (unsigned char*)F.out + DO_X1Q, (float*)(ws + WS_SA1), MP, M, c * NWAVES + F.wave, Gs * NWAVES, F.lane); sub_barrier(sbw, Gs, gen, tmo);
            { SETUP_P7(S, 1, NPP, Gs, c); pg8::gemm_phase(F.lds, S); } sub_barrier(sbw, Gs, gen, tmo);
            { SETUP_P8(S, 256, 32, Gs, c); pg8::gemm_phase(F.lds, S); } sub_barrier(sbw, Gs, gen, tmo);
            { SETUP_P9(S, 1024, 128, Gs, c); pg8::gemm_phase(F.lds, S); } sub_barrier(sbw, Gs, gen, tmo);
            { SETUP_P10(S, 1, NPP, Gs, c); pg8::gemm_phase(F.lds, S); } sub_barrier(sbw, Gs, gen, tmo);
            { const bf16_t* X2 = (const bf16_t*)(ws + WS_X1B); unsigned char* XQ = ws + WS_X2Q; float* SAp = (float*)(ws + WS_SA);
              quant_rows(X2, XQ, SAp, MP, M, c * NWAVES + F.wave, Gs * NWAVES, F.lane); }
            sub_barrier(sbw, Gs, gen, tmo);
            { SETUP_P11(S, 1, NPP, Gs, c, 0); pg8::gemm_phase(F.lds, S); } sub_barrier(sbw, Gs, gen, tmo);
            { SETUP_P12(S, 1, NPP, Gs, c); pg8::gemm_phase(F.lds, S); }
        }
        SETUP_P11(P, NPP, 0, G, c, nsc); pg8::gemm_phase(F.lds, P);
    } SEAM(11);
    if (IN(12)) { PHASE_WS(); SETUP_P12(P, NPP, 0, G, c); pg8::gemm_phase(F.lds, P); } SEAM(12);

    if (IN(13)) { PHASE_WS(); final_norm(F); }
#undef IN
#undef SEAM
}

extern "C" void kernel_launch(void* const* d_in, const int* in_sizes, int n_in, void* d_out, int out_size, void* d_ws, size_t ws_size, hipStream_t stream) {
    static int grid = 0;
    if (grid == 0) {
        if (n_in != 26 || ws_size < WS_END) { fprintf(stderr, "kernel_launch: unexpected n_in %d / ws_size %zu (need %zu)\n", n_in, ws_size, (size_t)WS_END); grid = -1; return; }
        int dev = 0, cus = 0, per_cu = 0;
        if (hipGetDevice(&dev) != hipSuccess || hipDeviceGetAttribute(&cus, hipDeviceAttributeMultiprocessorCount, dev) != hipSuccess) { grid = -1; return; }
        if (hipFuncSetAttribute((const void*)mk_fwd, hipFuncAttributeMaxDynamicSharedMemorySize, LDS_BYTES) != hipSuccess) { fprintf(stderr, "kernel_launch: hipFuncSetAttribute failed\n"); grid = -1; return; }
        if (hipOccupancyMaxActiveBlocksPerMultiprocessor(&per_cu, (const void*)mk_fwd, NWAVES * 64, LDS_BYTES) != hipSuccess || per_cu < 1) { fprintf(stderr, "kernel_launch: occupancy query says %d\n", per_cu); }
        (void)hipGetLastError();
        grid = cus;
    }
    if (grid < 0) return;
    (void)hipMemsetAsync((char*)d_ws + WS_CTL, 0, CTL_ZERO_BYTES, stream);
    Args a{};
    for (int i = 0; i < 26; ++i) a.in[i] = (const float*)d_in[i];
    a.out = (float*)d_out; a.ws = (unsigned char*)d_ws;
#if MK_ONE_LAUNCH
    a.ph_lo = 0; a.ph_hi = N_PHASES;
    hipLaunchKernelGGL(mk_fwd, dim3(grid), dim3(NWAVES * 64), LDS_BYTES, stream, a);
#else
    for (int p = 0; p < N_PHASES; ++p) { a.ph_lo = p; a.ph_hi = p + 1; hipLaunchKernelGGL(mk_fwd, dim3(grid), dim3(NWAVES * 64), LDS_BYTES, stream, a); }
#endif
}
```

```cpp
#include <hip/hip_runtime.h>
#include <cstdio>
#include <cstdint>

#ifndef MK_ONE_LAUNCH
#define MK_ONE_LAUNCH 1
#endif

#define LAS __attribute__((address_space(3)))
#define GAS __attribute__((address_space(1)))
typedef unsigned short bf16_t;
typedef short bf16x8 __attribute__((ext_vector_type(8)));
typedef float f32x4 __attribute__((ext_vector_type(4)));
typedef float f32x2 __attribute__((ext_vector_type(2)));
typedef unsigned u32x4 __attribute__((ext_vector_type(4)));
typedef int i32x4 __attribute__((ext_vector_type(4)));

typedef unsigned u32x2 __attribute__((ext_vector_type(2)));

constexpr int D = 4096, SEQ = 8192, NB = 2, DECB = 8, DECS = 32;
constexpr int MP = NB * SEQ;
constexpr int MS = DECB * DECS;
constexpr int M = MP + MS;
constexpr int HGW = 2048, NH = 16, DK = 128, DV = 128;
constexpr int CW = 2048;
constexpr int NMEM = 256, XH = 4, XD = 1024;
constexpr int FF = 11008;
constexpr int PROJW = 22528;
constexpr float EPS = 1e-6f;
constexpr int PW = 18432;
constexpr int PC_Q = 0, PC_CB = 2048, PC_U = 4096, PC_IV = 6144, PC_OG = 8192, PC_GA = 10240, PC_GB = 14336;
constexpr int NCHUNK = SEQ / 64;
constexpr int NSLOT_P = NB * NH * NCHUNK;
constexpr int NSLOT = NSLOT_P + DECB * NH;

constexpr size_t O_Y = 0, O_MK = (size_t)M * D, O_MV = O_MK + (size_t)NB * NMEM * D, O_HP = O_MV + (size_t)NB * NMEM * D,
                 O_CP = O_HP + (size_t)NB * NH * DK * DV, O_HS = O_CP + (size_t)NB * 2 * CW, O_CS = O_HS + (size_t)DECB * NH * DK * DV;

constexpr size_t MiB = 1u << 20;
constexpr size_t WS_CTL = 0, CTL_ZERO_BYTES = 1 * MiB;
constexpr int CW_BAR = 4096;
constexpr int CW_SUB = 8192;
constexpr int NSC = 16;
constexpr size_t WS_SS1 = 256 * 1024, WS_SS2 = 384 * 1024, WS_SS3 = 512 * 1024;
constexpr size_t WS_SBMAX = 640 * 1024;
constexpr size_t WS_SBMAXI = 768 * 1024;
constexpr size_t WS_SBMAXQ = 832 * 1024, WS_SBMAXO = 848 * 1024;
constexpr size_t WS_LB = 1 * MiB;
constexpr size_t WS_SA = 7 * MiB;
constexpr size_t WS_SB = 7 * MiB + 128 * 1024;
constexpr size_t WS_SAI = 7 * MiB + 256 * 1024;
constexpr size_t WS_SA1 = 7 * MiB + 512 * 1024, WS_SAO = 7 * MiB + 640 * 1024;
constexpr size_t WS_SBQ = 7 * MiB + 768 * 1024, WS_SBO = 7 * MiB + 800 * 1024;
constexpr size_t WS_SBI = 7 * MiB + 384 * 1024;
constexpr size_t WS_DEC = 2 * MiB;
constexpr size_t WS_LSUM = 5 * MiB;
constexpr size_t WS_MEMB = 8 * MiB;
constexpr size_t WS_MKB = 12 * MiB;
constexpr size_t WS_MVB = 16 * MiB;
constexpr size_t WS_MKS = 20 * MiB;
constexpr size_t WS_VTS = 36 * MiB;
constexpr size_t WS_WAB = 52 * MiB, WS_WO = 84 * MiB, WS_WXQ = 116 * MiB, WS_WKV = 148 * MiB, WS_WXO = 212 * MiB, WS_WGU = 244 * MiB, WS_WD = 416 * MiB;
constexpr size_t WS_WIN = 502 * MiB;
constexpr size_t WS_WIN8 = 582 * MiB;
constexpr size_t WS_XB = 678 * MiB;
constexpr size_t WS_ST = 502 * MiB;
constexpr size_t WS_PROJ = 808 * MiB;
constexpr size_t WS_LOGF = 1393 * MiB;
constexpr size_t WS_XBQ = 1523 * MiB;
constexpr size_t WS_WXQRM = 330 * MiB;
constexpr size_t WS_WXOT = 362 * MiB;
constexpr size_t WS_WPT = 394 * MiB;
constexpr size_t WS_VP = 132 * MiB;
constexpr size_t WS_END = 1588 * MiB;
constexpr size_t WS_MERGED = 502 * MiB;
constexpr size_t WS_X1B = 632 * MiB;
constexpr size_t WS_PB = 762 * MiB;
constexpr size_t WS_QX = 1393 * MiB;
constexpr size_t WS_OX = 502 * MiB;
constexpr size_t WS_X2Q = 502 * MiB;
constexpr size_t WS_GU = 808 * MiB;
static_assert(WS_WD + (size_t)D * FF * 2 <= WS_WIN && WS_WIN + (size_t)10240 * D * 2 <= WS_WIN8 && WS_WIN8 + (size_t)14336 * D <= WS_XB && WS_XB + (size_t)M * D * 2 <= WS_PROJ && WS_XBQ + (size_t)M * D <= WS_END, "ws map 1");
static_assert(WS_ST + (size_t)NSLOT * DK * DV * 4 <= WS_PROJ && WS_PROJ + (size_t)M * PW * 2 <= WS_LOGF && WS_LOGF + (size_t)M * HGW * 4 <= WS_END, "ws map 2");
static_assert(WS_PB + (size_t)M * 1024 * 2 <= WS_PROJ && WS_GU + (size_t)M * FF * 2 <= WS_LOGF, "ws map 3");

constexpr size_t DO_X1Q = 0, DO_OXQ = 80 * MiB;

constexpr int RING_BYTES = 131072;
constexpr int LDSX_OFF = RING_BYTES;
constexpr int MISC_OFF = RING_BYTES + 8192;
constexpr int RSC_OFF = MISC_OFF + 256;
constexpr int LDS_BYTES = RSC_OFF + 16384;
constexpr int NWAVES = 8;

typedef __bf16 bf16x2_n __attribute__((ext_vector_type(2)));
__device__ __forceinline__ unsigned pk2(float lo, float hi) { return __builtin_bit_cast(unsigned, __builtin_convertvector((f32x2){lo, hi}, bf16x2_n)); }
__device__ __forceinline__ unsigned f2bf(float f) { return pk2(f, 0.f) & 0xffffu; }
__device__ __forceinline__ unsigned cvt_pk_bf16(float lo, float hi) { unsigned r; asm volatile("s_nop 0\n\tv_cvt_pk_bf16_f32 %0, %1, %2" : "=v"(r) : "v"(lo), "v"(hi)); return r; }
__device__ __forceinline__ float bf_lo(unsigned w) { return __builtin_bit_cast(float, w << 16); }
__device__ __forceinline__ float bf_hi(unsigned w) { return __builtin_bit_cast(float, w & 0xffff0000u); }
__device__ __forceinline__ float fast_rcp(float x) { return __builtin_amdgcn_rcpf(x); }
__device__ __forceinline__ float fast_exp2(float x) { return __builtin_amdgcn_exp2f(x); }
__device__ __forceinline__ float sigmoid_f(float x) { return fast_rcp(1.0f + fast_exp2(-1.44269504089f * x)); }
__device__ __forceinline__ float wave_sum(float v) {
#pragma unroll
    for (int o = 1; o < 64; o <<= 1) v += __shfl_xor(v, o);
    return v;
}
#define LDS_WAIT() asm volatile("s_waitcnt lgkmcnt(0)" ::: "memory")
#define VM_WAIT() asm volatile("s_waitcnt vmcnt(0)" ::: "memory")

namespace pg8 {
constexpr int BM = 256, BK = 64, HALF = 128, HTB = HALF * BK * 2, STAGE_BYTES = 8 * HTB, NXCD = 8, WGM = 4;
__host__ __device__ __forceinline__ int lds_byte(int r, int c) { const int st = (r >> 4) * 2 + (c >> 5), rr = r & 15, cc = c & 31, ob = rr * 64 + cc * 2; return st * 1024 + (ob ^ (((ob >> 9) & 1) << 5)); }
__host__ __device__ __forceinline__ void stage_rc(int b, int& R, int& C) { const int st = b / 1024, sb = b % 1024, swz = sb ^ (((sb >> 9) & 1) << 5); R = (st >> 1) * 16 + swz / 64; C = (st & 1) * 32 + (swz % 64) / 2; }
__host__ __device__ __forceinline__ int perm32(int rho) { const int n = rho >> 4, i = rho & 15; return 8 * (i >> 2) + 4 * n + (i & 3); }

struct Unit { int pm, pn, z; };

__device__ __forceinline__ void static_unit(int L, int nM, int nN, Unit& u) {
    const int nwg = nM * nN; int wgid = L;
    { const int q = nwg / NXCD, r = nwg % NXCD, xcd = wgid % NXCD, off = wgid / NXCD; wgid = (xcd < r ? xcd * (q + 1) : r * (q + 1) + (xcd - r) * q) + off; }
    const int nig = WGM * nN, gid = wgid / nig, fm = gid * WGM, gsz = (nM - fm) < WGM ? (nM - fm) : WGM;
    u.pm = fm + ((wgid % nig) % gsz); u.pn = (wgid % nig) / gsz;
}

typedef f32x4 Acc[2][2][4][2];

template <class Prob, bool ALIGN = true>
__device__ __forceinline__ void gemm_phase(LAS unsigned char* lds, const Prob& P) {
    int tid = threadIdx.x; asm volatile("" : "+v"(tid));
    const int wid = __builtin_amdgcn_readfirstlane(tid >> 6), lane = tid & 63, wr = wid >> 2, wc = wid & 3, fr = lane & 15, fq = lane >> 4;
    const int nt = P.nt;
    const unsigned lda = P.lda, ldb = P.ldb;
    unsigned voffA[2], voffB[2];
#pragma unroll
    for (int i = 0; i < 2; ++i) { int R, C; stage_rc(tid * 16 + i * 8192, R, C); const int Rb = (R & ~31) + perm32(R & 31);
        voffA[i] = (unsigned)R * lda + (unsigned)C * 2u; voffB[i] = (unsigned)Rb * ldb + (unsigned)C * 2u; }
    const size_t kstep = (size_t)(BK * 2);
    const size_t hstepA = (size_t)HALF * lda, hstepB = (size_t)HALF * ldb;
    const unsigned ldsw = (unsigned)wid * 1024u;
    const int aoff = lds_byte(wr * 64 + fr, fq * 8), boff = lds_byte(wc * 32 + fr, fq * 8);
#define PG8_SA(b, h) (((b) * 2 + (h)) * HTB)
#define PG8_SB(b, h) ((4 + (b) * 2 + (h)) * HTB)
#define PG8_STAGE(bufoff, gbase, voff) do { _Pragma("unroll") for (int _i = 0; _i < 2; ++_i) \
        __builtin_amdgcn_global_load_lds((const unsigned*)((const char*)(gbase) + (voff)[_i]), (LAS unsigned*)(lds + (bufoff) + ldsw + _i * 8192), 16, 0, 0); } while (0)
#define PG8_LDA(dst, b, h) do { _Pragma("unroll") for (int m = 0; m < 4; ++m) _Pragma("unroll") for (int k = 0; k < 2; ++k) dst[m][k] = *(const LAS bf16x8*)(lds + PG8_SA(b, h) + aoff + m * 2048 + k * 1024); } while (0)
#define PG8_LDB(dst, b, h) do { _Pragma("unroll") for (int n = 0; n < 2; ++n) _Pragma("unroll") for (int k = 0; k < 2; ++k) dst[n][k] = *(const LAS bf16x8*)(lds + PG8_SB(b, h) + boff + n * 2048 + k * 1024); } while (0)
#define PG8_MMA(ai, bj, At, Bt) do { __builtin_amdgcn_s_setprio(1); _Pragma("unroll") for (int m = 0; m < 4; ++m) _Pragma("unroll") for (int n = 0; n < 2; ++n) _Pragma("unroll") for (int k = 0; k < 2; ++k) \
        { if constexpr (Prob::I8) acc[ai][bj][m][n] = __builtin_bit_cast(f32x4, __builtin_amdgcn_mfma_i32_16x16x64_i8(__builtin_bit_cast(i32x4, Bt[n][k]), __builtin_bit_cast(i32x4, At[m][k]), __builtin_bit_cast(i32x4, acc[ai][bj][m][n]), 0, 0, 0)); \
          else acc[ai][bj][m][n] = __builtin_amdgcn_mfma_f32_16x16x32_bf16(Bt[n][k], At[m][k], acc[ai][bj][m][n], 0, 0, 0); } __builtin_amdgcn_s_setprio(0); } while (0)
#define PG8_WAIT_V(n) asm volatile("s_waitcnt vmcnt(" #n ")" ::: "memory")
#define PG8_WAIT_L(n) asm volatile("s_waitcnt lgkmcnt(" #n ")" ::: "memory")
#define PG8_BAR __builtin_amdgcn_s_barrier()
#define PG8_SCHED __builtin_amdgcn_sched_barrier(0)
    Unit cur, nxt; int ui = 0;
    if (!P.next(0, cur)) return;
    Acc acc;
#pragma unroll
    for (int a = 0; a < 2; ++a)
#pragma unroll
        for (int b = 0; b < 2; ++b)
#pragma unroll
            for (int m = 0; m < 4; ++m)
#pragma unroll
                for (int n = 0; n < 2; ++n) acc[a][b][m][n] = (f32x4){0.f, 0.f, 0.f, 0.f};
    bf16x8 At[4][2], B0[2][2], B1[2][2];
    const char* cA = P.a_ptr(cur); const char* cB = P.b_ptr(cur);
    PG8_STAGE(PG8_SB(0, 0), cB, voffB); PG8_STAGE(PG8_SB(0, 1), cB + hstepB, voffB); PG8_STAGE(PG8_SA(0, 0), cA, voffA); PG8_STAGE(PG8_SA(0, 1), cA + hstepA, voffA);
    if (wr == 1) PG8_BAR;
    PG8_WAIT_V(2); PG8_BAR;
    PG8_STAGE(PG8_SB(1, 0), cB + kstep, voffB); PG8_STAGE(PG8_SA(1, 0), cA + kstep, voffA); PG8_STAGE(PG8_SB(1, 1), cB + hstepB + kstep, voffB);
    PG8_WAIT_V(6); PG8_BAR;
    for (;;) {
        const bool has_next = P.next(ui + 1, nxt);
        const char* nA = has_next ? P.a_ptr(nxt) : cA; const char* nB = has_next ? P.b_ptr(nxt) : cB;
        for (int t = 0; t < nt; t += 2) {
            const bool last = (t == nt - 2);
            const char* a1 = cA + (size_t)(t + 1) * kstep;
            const char* a2 = last ? nA : cA + (size_t)(t + 2) * kstep; const char* b2 = last ? nB : cB + (size_t)(t + 2) * kstep;
            const char* a3 = a2 + kstep; const char* b3 = b2 + kstep;
            if constexpr (Prob::HAS_MID) { if (t == (nt >> 1)) P.mid(acc, cur, wr, wc, fr, fq); }
            PG8_LDB(B0, 0, 0); PG8_LDB(B1, 0, 1); PG8_SCHED; PG8_LDA(At, 0, 0); PG8_STAGE(PG8_SA(1, 1), a1 + hstepA, voffA);
            PG8_WAIT_V(8); PG8_WAIT_L(0); PG8_BAR; PG8_MMA(0, 0, At, B0); PG8_MMA(0, 1, At, B1); PG8_BAR; PG8_SCHED;
            PG8_LDA(At, 0, 1); PG8_STAGE(PG8_SB(0, 0), b2, voffB); PG8_STAGE(PG8_SB(0, 1), b2 + hstepB, voffB); PG8_STAGE(PG8_SA(0, 0), a2, voffA);
            PG8_WAIT_V(8); PG8_WAIT_L(0); PG8_BAR; PG8_MMA(1, 0, At, B0); PG8_MMA(1, 1, At, B1); PG8_BAR; PG8_SCHED;
            PG8_LDB(B0, 1, 0); PG8_LDB(B1, 1, 1); PG8_SCHED; PG8_LDA(At, 1, 0); PG8_STAGE(PG8_SA(0, 1), a2 + hstepA, voffA);
            PG8_WAIT_V(8); PG8_WAIT_L(0); PG8_BAR; PG8_MMA(0, 0, At, B0); PG8_MMA(0, 1, At, B1); PG8_BAR; PG8_SCHED;
            PG8_LDA(At, 1, 1); PG8_STAGE(PG8_SB(1, 0), b3, voffB); PG8_STAGE(PG8_SB(1, 1), b3 + hstepB, voffB); PG8_STAGE(PG8_SA(1, 0), a3, voffA);
            PG8_WAIT_V(8); PG8_WAIT_L(0); PG8_BAR; PG8_MMA(1, 0, At, B0); PG8_MMA(1, 1, At, B1); PG8_BAR; PG8_SCHED;
        }
        if constexpr (ALIGN) { if (wr == 0) PG8_BAR; }
        P.epi(acc, cur, wr, wc, fr, fq, wid, lane);
        if (!has_next) break;
#pragma unroll
        for (int a = 0; a < 2; ++a)
#pragma unroll
            for (int b = 0; b < 2; ++b)
#pragma unroll
                for (int m = 0; m < 4; ++m)
#pragma unroll
                    for (int n = 0; n < 2; ++n) acc[a][b][m][n] = (f32x4){0.f, 0.f, 0.f, 0.f};
        cur = nxt; cA = nA; cB = nB; ++ui;
        if constexpr (ALIGN) { if (wr == 1) PG8_BAR; }
    }
    PG8_WAIT_V(0);
    if constexpr (!ALIGN) { if (wr == 0) PG8_BAR; }
    PG8_BAR;
#undef PG8_SA
#undef PG8_SB
#undef PG8_STAGE
#undef PG8_LDA
#undef PG8_LDB
#undef PG8_MMA
#undef PG8_WAIT_V
#undef PG8_WAIT_L
#undef PG8_BAR
#undef PG8_SCHED
}
}
using pg8::Unit; using pg8::Acc;

#define XB_TMO      128
#define XB_XCNT(j)  (256  + 64 * (j))
#define XB_XSUB(j)  (1280 + 64 * (j))
#define XB_XGEN(j)  (2304 + 64 * (j))
#define XB_TOP      3328
#define XB_TOPGEN   3392
#define XCD_BAR_WORDS 3456
#define XB_SPIN_CAP (1u << 18)
__device__ __forceinline__ unsigned xb_ld(unsigned* p)              { return __hip_atomic_load(p, __ATOMIC_RELAXED, __HIP_MEMORY_SCOPE_AGENT); }
__device__ __forceinline__ unsigned xb_add(unsigned* p, unsigned v) { return __hip_atomic_fetch_add(p, v, __ATOMIC_RELAXED, __HIP_MEMORY_SCOPE_AGENT); }
__device__ __forceinline__ unsigned xb_xcc_id() { return (unsigned)__builtin_amdgcn_s_getreg((3 << 11) | 20) & 0xFu; }
#define XB_SPIN(cond, bar) do { unsigned _sp = 0; while (cond) { __builtin_amdgcn_s_sleep(1); \
    if ((++_sp & 255u) == 0u) { if (xb_ld(&(bar)[XB_TMO])) break; if (_sp > XB_SPIN_CAP) { atomicAdd(&(bar)[XB_TMO], 1u); break; } } } } while (0)
struct XcdBarrier { unsigned* bar; unsigned x; volatile LAS unsigned* st; };
__device__ __forceinline__ XcdBarrier xcd_barrier_post(unsigned* bar, volatile LAS unsigned* st) {
    XcdBarrier b; b.bar = bar; b.x = xb_xcc_id(); b.st = st;
    if (threadIdx.x == 0) (void)xb_add(&bar[XB_XCNT(b.x)], 1u);
    return b;
}
__device__ __forceinline__ void xcd_barrier_complete(unsigned* bar, unsigned x, unsigned& nloc, unsigned& nx) {
    const unsigned G = gridDim.x * gridDim.y * gridDim.z;
    unsigned sum, cnt, mine, sp = 0u;
    for (;;) {
        sum = 0u; cnt = 0u; mine = 0u;
#pragma unroll
        for (unsigned j = 0; j < 16; ++j) { const unsigned c = xb_ld(&bar[XB_XCNT(j)]); sum += c; cnt += (c > 0u) ? 1u : 0u; mine = (j == x) ? c : mine; }
        if (sum == G) break;
        __builtin_amdgcn_s_sleep(1);
        if ((++sp & 255u) == 0u) { if (xb_ld(&bar[XB_TMO])) break; if (sp > XB_SPIN_CAP) { atomicAdd(&bar[XB_TMO], 1u); break; } }
    }
    nloc = mine > 0u ? mine : 1u; nx = cnt > 0u ? cnt : 1u;
}
__device__ __forceinline__ void xcd_barrier(const XcdBarrier& b) {
    asm volatile("s_waitcnt vmcnt(0)" ::: "memory");
    __syncthreads();
    if (threadIdx.x == 0) {
        unsigned* bar = b.bar;
        __builtin_amdgcn_s_waitcnt(0);
        unsigned nloc = b.st[0], nx = b.st[1];
        if (nloc == 0u) { xcd_barrier_complete(bar, b.x, nloc, nx); b.st[0] = nloc; b.st[1] = nx; }
        const unsigned old = xb_add(&bar[XB_XSUB(b.x)], 1u);
        const unsigned gen = old / nloc;
        if (old + 1u == (gen + 1u) * nloc) {
            __builtin_amdgcn_fence(__ATOMIC_RELEASE, "agent");
            asm volatile("s_waitcnt vmcnt(0)" ::: "memory");
            const unsigned og = xb_add(&bar[XB_TOP], 1u);
            const unsigned tg = og / nx;
            if (og + 1u == (tg + 1u) * nx) xb_add(&bar[XB_TOPGEN], 1u);
            else XB_SPIN(xb_ld(&bar[XB_TOPGEN]) == tg, bar);
            __builtin_amdgcn_fence(__ATOMIC_ACQUIRE, "agent");
            xb_add(&bar[XB_XGEN(b.x)], 1u);
            asm volatile("s_waitcnt vmcnt(0)" ::: "memory");
        } else {
            XB_SPIN(xb_ld(&bar[XB_XGEN(b.x)]) == gen, bar);
            __builtin_amdgcn_fence(__ATOMIC_ACQUIRE, "agent");
            asm volatile("s_waitcnt vmcnt(0)" ::: "memory");
        }
    }
    __syncthreads();
}

__device__ __forceinline__ void sub_barrier(unsigned* w, unsigned n, unsigned& gen, unsigned* tmo) {
    asm volatile("s_waitcnt vmcnt(0)" ::: "memory");
    __syncthreads();
    if (threadIdx.x == 0) {
        __builtin_amdgcn_fence(__ATOMIC_RELEASE, "agent");
        asm volatile("s_waitcnt vmcnt(0)" ::: "memory");
        (void)xb_add(w, 1u);
        const unsigned target = (gen + 1u) * n; unsigned sp = 0;
        while (xb_ld(w) < target) { __builtin_amdgcn_s_sleep(1); if ((++sp & 255u) == 0u) { if (xb_ld(tmo)) break; if (sp > XB_SPIN_CAP) { atomicAdd(tmo, 1u); break; } } }
        __builtin_amdgcn_fence(__ATOMIC_ACQUIRE, "agent");
        asm volatile("s_waitcnt vmcnt(0)" ::: "memory");
    }
    ++gen;
    __syncthreads();
}

struct Args { const float* in[26]; float* out; unsigned char* ws; int ph_lo, ph_hi; };
enum { I_XP = 0, I_XS, I_CK, I_CV, I_SH, I_SC, I_MEM, I_NMIX, I_WIN, I_LBL, I_HGN, I_CONVW, I_WA, I_WB, I_WO, I_NXA, I_NMEM, I_WXQ, I_WXK, I_WXV, I_WXO, I_NFFN, I_WG, I_WU, I_WDN, I_NFIN };

struct Frame {
    LAS unsigned char* lds;
    int tid, lane, wave, G, bid;
    const float* const* in; float* out; unsigned char* ws;
};

struct CvtJob { const float* W; int ldw, k0, n0; bf16_t* WT; int ldd, drow0, dk0; const float* gain; };
__device__ __forceinline__ void cvt_load(const CvtJob& j, f32x4 (&v)[8], int lane) {
#pragma unroll
    for (int i = 0; i < 8; ++i) v[i] = *(const f32x4*)(j.W + (size_t)(j.k0 + 8 * i + (lane >> 3)) * j.ldw + j.n0 + 4 * (lane & 7));
}
__device__ __forceinline__ void cvt_store(const CvtJob& j, const f32x4 (&v)[8], LAS float* scr, int lane) {
#pragma unroll
    for (int i = 0; i < 8; ++i) { LAS float* d = scr + (8 * i + (lane >> 3)) * 33 + 4 * (lane & 7); d[0] = v[i][0]; d[1] = v[i][1]; d[2] = v[i][2]; d[3] = v[i][3]; }
    LDS_WAIT(); asm volatile("" ::: "memory");
    const int c = lane & 7;
    float g[8];
#pragma unroll
    for (int i = 0; i < 8; ++i) g[i] = j.gain ? j.gain[j.k0 + 8 * c + i] : 1.0f;
#pragma unroll
    for (int q = 0; q < 4; ++q) { const int n = (lane >> 3) + 8 * q; const LAS float* s = scr + (8 * c) * 33 + n;
        u32x4 o; o.x = cvt_pk_bf16(s[0 * 33] * g[0], s[1 * 33] * g[1]); o.y = cvt_pk_bf16(s[2 * 33] * g[2], s[3 * 33] * g[3]); o.z = cvt_pk_bf16(s[4 * 33] * g[4], s[5 * 33] * g[5]); o.w = cvt_pk_bf16(s[6 * 33] * g[6], s[7 * 33] * g[7]);
        *(u32x4*)(j.WT + (size_t)(j.drow0 + n) * j.ldd + j.dk0 + j.k0 + 8 * c) = o; }
    LDS_WAIT(); asm volatile("" ::: "memory");
}
__device__ __forceinline__ int win_src0(int seg) { return seg == 0 ? 0 : seg == 1 ? 8192 : seg == 2 ? 12288 : seg == 3 ? 4096 : 2048; }
__device__ __forceinline__ int win_dst(int seg, int j) {
    if (seg == 0) return j;
    if (seg == 1) return 2048 + 256 * (j >> 7) + (j & 127);
    if (seg == 2) return 2048 + 256 * (j >> 7) + 128 + (j & 127);
    if (seg == 3) return 6144 + j;
    return 8192 + j;
}
__device__ __forceinline__ void norm_row_to_bf16(const float* xrow, const float* gain, bf16_t* orow, int lane, unsigned char* qrow = nullptr, float* sa = nullptr) {
    const f32x4* xr = (const f32x4*)xrow + lane; const f32x4* gr = (const f32x4*)gain + lane;
    f32x4 v[16]; float s = 0.f;
#pragma unroll
    for (int j = 0; j < 16; ++j) { v[j] = xr[64 * j]; s += (v[j].x * v[j].x + v[j].y * v[j].y) + (v[j].z * v[j].z + v[j].w * v[j].w); }
    const float rstd = 1.0f / sqrtf(wave_sum(s) * (1.0f / D) + EPS);
    u32x2* o8 = (u32x2*)orow + lane; float mx = 0.f;
#pragma unroll
    for (int j = 0; j < 16; ++j) { const f32x4 g = gr[64 * j]; v[j] = v[j] * rstd * g; u32x2 w; w.x = pk2(v[j].x, v[j].y); w.y = pk2(v[j].z, v[j].w); o8[64 * j] = w;
        mx = fmaxf(mx, fmaxf(fmaxf(fabsf(v[j].x), fabsf(v[j].y)), fmaxf(fabsf(v[j].z), fabsf(v[j].w)))); }
    if (qrow) {
#pragma unroll
        for (int o = 1; o < 64; o <<= 1) mx = fmaxf(mx, __shfl_xor(mx, o));
        const float inv = mx > 0.f ? 127.0f / mx : 0.f; unsigned* q4 = (unsigned*)qrow + lane;
#pragma unroll
        for (int j = 0; j < 16; ++j) q4[64 * j] = ((unsigned)(int)__builtin_rintf(v[j].x * inv) & 0xffu) | (((unsigned)(int)__builtin_rintf(v[j].y * inv) & 0xffu) << 8) | (((unsigned)(int)__builtin_rintf(v[j].z * inv) & 0xffu) << 16) | (((unsigned)(int)__builtin_rintf(v[j].w * inv) & 0xffu) << 24);
        if (lane == 0) *sa = mx * (1.0f / 127.0f);
    }
}
constexpr int IT_WIN = (D / 64) * (8192 / 32), IT_WIN8 = (D / 64) * (14336 / 32), IT_WA = (HGW / 64) * (D / 32), IT_SQ = (D / 64) * (D / 32), IT_GU = (D / 64) * (FF / 32), IT_WD = (FF / 64) * (D / 32), IT_CV = (NMEM / 64) * (D / 32);
constexpr int NIT_W = IT_WIN + 2 * IT_WA + 4 * IT_SQ + IT_WD + DECB * IT_CV;

__device__ __forceinline__ CvtJob cvt_job(const Frame& F, int it) {
    unsigned char* ws = F.ws; CvtJob j; int r = it;
#define CVT_SET(W_, ldw_, nb_, WT_, ldd_, drow_, dk_, gain_) do { const int kb = r / (nb_), n0 = (r % (nb_)) * 32; j.W = (W_); j.ldw = (ldw_); j.k0 = kb * 64; j.n0 = n0; j.WT = (bf16_t*)(WT_); j.ldd = (ldd_); j.drow0 = (drow_); j.dk0 = (dk_); j.gain = (gain_); return j; } while (0)
    if (r < IT_WIN) { const int kb = r / 256, cbk = r % 256 + 64, seg = cbk >> 6, j0 = (cbk & 63) * 32;
        j.W = F.in[I_WIN]; j.ldw = PROJW; j.k0 = kb * 64; j.n0 = win_src0(seg) + j0; j.WT = (bf16_t*)(ws + WS_WIN); j.ldd = D; j.drow0 = win_dst(seg, j0); j.dk0 = 0; j.gain = nullptr; return j; } r -= IT_WIN;
    if (r < IT_SQ) CVT_SET(F.in[I_WXK], D, D / 32, ws + WS_WKV, D, n0, 0, nullptr); r -= IT_SQ;
    if (r < IT_SQ) CVT_SET(F.in[I_WXV], D, D / 32, ws + WS_WKV, D, D + n0, 0, nullptr); r -= IT_SQ;
    if (r < DECB * IT_CV) { const int sidx = r / IT_CV; r = r % IT_CV; CVT_SET(F.in[I_CV] + (size_t)sidx * NMEM * D, D, D / 32, ws + WS_VTS + (size_t)sidx * D * NMEM * 2, NMEM, n0, 0, nullptr); } r -= DECB * IT_CV;
    if (r < IT_WA) CVT_SET(F.in[I_WA], D, D / 32, ws + WS_WAB, D, n0, 0, nullptr); r -= IT_WA;
    if (r < IT_WA) CVT_SET(F.in[I_WB], D, D / 32, ws + WS_WAB, D, n0, HGW, nullptr); r -= IT_WA;
    if (r < IT_SQ) CVT_SET(F.in[I_WO], D, D / 32, ws + WS_WO, D, n0, 0, nullptr); r -= IT_SQ;
    if (r < IT_WD) CVT_SET(F.in[I_WDN], D, D / 32, ws + WS_WD, FF, n0, 0, nullptr); r -= IT_WD;
    CVT_SET(F.in[I_WXO], D, D / 32, ws + WS_WXOT, D, n0, 0, nullptr);
#undef CVT_SET
}
__device__ __forceinline__ void convert_items(Frame& F, int lo, int hi, int w, int NW) {
    LAS float* scr = (LAS float*)(F.lds + F.wave * 16384);
    int it = lo + w; if (it >= hi) return;
    CvtJob cur = cvt_job(F, it); f32x4 v[8]; cvt_load(cur, v, F.lane);
    for (;;) {
        const int nx = it + NW; const bool more = nx < hi;
        CvtJob nj = cur; f32x4 vn[8];
        if (more) { nj = cvt_job(F, nx); cvt_load(nj, vn, F.lane); }
        cvt_store(cur, v, scr, F.lane);
        if (!more) break;
#pragma unroll
        for (int i = 0; i < 8; ++i) v[i] = vn[i];
        cur = nj; it = nx;
    }
}
constexpr int NIT_P0 = IT_WIN + 2 * IT_SQ + DECB * IT_CV;
static_assert(NIT_P0 + 2 * IT_WA + 2 * IT_SQ + IT_WD == NIT_W, "item list");

constexpr int NIT_Q8 = 2 * IT_GU + IT_WIN8 + IT_SQ;
struct Q8Job { const float* W; int ldw, k0, n0, drow0; const float* gain; unsigned* smax; float* sb; unsigned char* WQ; };
__device__ __forceinline__ Q8Job q8_job(const Frame& F, int it) {
    Q8Job j; unsigned char* ws = F.ws;
    if (it < 2 * IT_GU) { const int mat = it >= IT_GU ? 1 : 0, r = it - mat * IT_GU, nb = FF / 32, kb = r / nb, n0 = (r % nb) * 32;
        j.W = F.in[mat ? I_WU : I_WG]; j.ldw = FF; j.k0 = kb * 64; j.n0 = n0; j.drow0 = 256 * (n0 >> 7) + 128 * mat + (n0 & 127); j.gain = F.in[I_NFFN];
        j.smax = (unsigned*)(ws + WS_SBMAX); j.sb = (float*)(ws + WS_SB); j.WQ = ws + WS_WGU; return j; }
    if (it >= 2 * IT_GU + IT_WIN8) { const int r = it - (2 * IT_GU + IT_WIN8), nb = D / 32, kb = r / nb, n0 = (r % nb) * 32;
        j.W = F.in[I_WXQ]; j.ldw = D; j.k0 = kb * 64; j.n0 = n0; j.drow0 = n0; j.gain = F.in[I_NXA];
        j.smax = (unsigned*)(ws + WS_SBMAXQ); j.sb = (float*)(ws + WS_SBQ); j.WQ = ws + WS_WXQ; return j; }
    const int r = it - 2 * IT_GU, kb = r / 448, cb = r % 448;
    int src0, dst0, j0;
    if (cb < 64) { src0 = 10240; dst0 = 0; j0 = cb * 32; } else if (cb < 128) { src0 = 6144; dst0 = 2048; j0 = (cb - 64) * 32; }
    else if (cb < 256) { src0 = 14336; dst0 = 4096; j0 = (cb - 128) * 32; } else if (cb < 384) { src0 = 18432; dst0 = 8192; j0 = (cb - 256) * 32; } else { src0 = 0; dst0 = 12288; j0 = (cb - 384) * 32; }
    j.W = F.in[I_WIN]; j.ldw = PROJW; j.k0 = kb * 64; j.n0 = src0 + j0; j.drow0 = dst0 + j0; j.gain = nullptr;
    j.smax = (unsigned*)(ws + WS_SBMAXI); j.sb = (float*)(ws + WS_SBI); j.WQ = ws + WS_WIN8; return j;
}
__device__ __forceinline__ void q8_load(const Q8Job& j, f32x4 (&v)[8], float (&g)[8], int lane) {
#pragma unroll
    for (int i = 0; i < 8; ++i) { const int k = j.k0 + 8 * i + (lane >> 3); v[i] = *(const f32x4*)(j.W + (size_t)k * j.ldw + j.n0 + 4 * (lane & 7)); g[i] = j.gain ? j.gain[k] : 1.0f; }
}
__device__ __forceinline__ void q8_cm_load(const float* p, size_t ldw, const float* gain, int k, f32x4 (&v)[8], float (&g)[8]) {
#pragma unroll
    for (int i = 0; i < 8; ++i) { v[i] = *(const f32x4*)(p + (size_t)i * ldw); g[i] = gain ? gain[k + i] : 1.0f; }
}
__device__ __forceinline__ void q8_colmax(Frame& F, int lo, int hi, int w, int NW) {
    const int lane = F.lane;
    for (int it = lo + 8 * w; it < hi; it += 8 * NW) {
        const Q8Job j = q8_job(F, it); const int drow_l = q8_job(F, it + (lane >> 3)).drow0;
        const float* p = j.W + (size_t)j.k0 * j.ldw + j.n0 + 4 * lane; const size_t ldw = (size_t)j.ldw;
        f32x4 mx = (f32x4){0.f, 0.f, 0.f, 0.f}; f32x4 v[8]; float g[8];
        q8_cm_load(p, ldw, j.gain, j.k0, v, g);
#pragma nounroll
        for (int r = 8; r < 64; r += 8) { f32x4 vn[8]; float gn[8];
            q8_cm_load(p + (size_t)r * ldw, ldw, j.gain, j.k0 + r, vn, gn);
#pragma unroll
            for (int i = 0; i < 8; ++i) { const f32x4 x = v[i] * g[i];
                mx[0] = fmaxf(mx[0], fabsf(x[0])); mx[1] = fmaxf(mx[1], fabsf(x[1])); mx[2] = fmaxf(mx[2], fabsf(x[2])); mx[3] = fmaxf(mx[3], fabsf(x[3])); }
#pragma unroll
            for (int i = 0; i < 8; ++i) { v[i] = vn[i]; g[i] = gn[i]; } }
#pragma unroll
        for (int i = 0; i < 8; ++i) { const f32x4 x = v[i] * g[i];
            mx[0] = fmaxf(mx[0], fabsf(x[0])); mx[1] = fmaxf(mx[1], fabsf(x[1])); mx[2] = fmaxf(mx[2], fabsf(x[2])); mx[3] = fmaxf(mx[3], fabsf(x[3])); }
        unsigned* d = j.smax + drow_l + 4 * (lane & 7);
#pragma unroll
        for (int q = 0; q < 4; ++q) atomicMax(d + q, __float_as_uint(mx[q]));
    }
}
__device__ __forceinline__ void q8_quant(Frame& F, int lo, int hi, int w, int NW) {
    const int lane = F.lane; LAS float* scr = (LAS float*)(F.lds + F.wave * 16384);
    int it = lo + 2 * w; if (it >= hi) return;
    Q8Job cur = q8_job(F, it); f32x4 v[8]; float g[8]; q8_load(cur, v, g, lane);
    u32x4 cmw = *(const u32x4*)(cur.smax + cur.drow0 + 4 * (lane & 7));
    for (;;) {
        const int nx = ((it - lo) & 1) ? it + 2 * NW - 1 : it + 1; const bool more = nx < hi;
        Q8Job nj = cur; f32x4 vn[8]; float gn[8]; u32x4 cmn = cmw;
        if (more) { nj = q8_job(F, nx); q8_load(nj, vn, gn, lane); cmn = *(const u32x4*)(nj.smax + nj.drow0 + 4 * (lane & 7)); }
        f32x4 inv; const float cm[4] = {__uint_as_float(cmw.x), __uint_as_float(cmw.y), __uint_as_float(cmw.z), __uint_as_float(cmw.w)};
#pragma unroll
        for (int q = 0; q < 4; ++q) inv[q] = cm[q] > 0.f ? 127.0f / cm[q] : 0.f;
        if (cur.k0 == 0 && lane < 8) *(f32x4*)(cur.sb + cur.drow0 + 4 * lane) = (f32x4){cm[0], cm[1], cm[2], cm[3]} * (1.0f / 127.0f);
#pragma unroll
        for (int i = 0; i < 8; ++i) { const f32x4 x = v[i] * g[i] * inv;
            LAS float* d = scr + (8 * i + (lane >> 3)) * 33 + 4 * (lane & 7); d[0] = __builtin_rintf(x[0]); d[1] = __builtin_rintf(x[1]); d[2] = __builtin_rintf(x[2]); d[3] = __builtin_rintf(x[3]); }
        LDS_WAIT(); asm volatile("" ::: "memory");
        const int c = lane & 7;
#pragma unroll
        for (int q = 0; q < 4; ++q) { const int n = (lane >> 3) + 8 * q; const LAS float* sp = scr + (8 * c) * 33 + n;
            unsigned b[8];
#pragma unroll
            for (int i = 0; i < 8; ++i) b[i] = (unsigned)(int)sp[i * 33] & 0xffu;
            u32x2 o; o.x = b[0] | (b[1] << 8) | (b[2] << 16) | (b[3] << 24); o.y = b[4] | (b[5] << 8) | (b[6] << 16) | (b[7] << 24);
            *(u32x2*)(cur.WQ + (size_t)(cur.drow0 + n) * D + cur.k0 + 8 * c) = o; }
        LDS_WAIT(); asm volatile("" ::: "memory");
        if (!more) break;
#pragma unroll
        for (int i = 0; i < 8; ++i) { v[i] = vn[i]; g[i] = gn[i]; }
        cmw = cmn; cur = nj; it = nx;
    }
}
__device__ __forceinline__ void quant_row_load(const bf16_t* xrow, u32x4 (&w)[8], int lane) {
#pragma unroll
    for (int j = 0; j < 8; ++j) w[j] = *(const u32x4*)(xrow + (size_t)(j * 64 + lane) * 8);
}
__device__ __forceinline__ void quant_row_finish(const u32x4 (&w)[8], unsigned char* qrow, float* sa, int lane) {
    float mx = 0.f;
#pragma unroll
    for (int j = 0; j < 8; ++j) {
        mx = fmaxf(mx, fmaxf(fmaxf(fabsf(bf_lo(w[j].x)), fabsf(bf_hi(w[j].x))), fmaxf(fabsf(bf_lo(w[j].y)), fabsf(bf_hi(w[j].y)))));
        mx = fmaxf(mx, fmaxf(fmaxf(fabsf(bf_lo(w[j].z)), fabsf(bf_hi(w[j].z))), fmaxf(fabsf(bf_lo(w[j].w)), fabsf(bf_hi(w[j].w))))); }
#pragma unroll
    for (int o = 1; o < 64; o <<= 1) mx = fmaxf(mx, __shfl_xor(mx, o));
    const float inv = mx > 0.f ? 127.0f / mx : 0.f;
#pragma unroll
    for (int j = 0; j < 8; ++j) {
        const unsigned b0 = (unsigned)(int)__builtin_rintf(bf_lo(w[j].x) * inv) & 0xffu, b1 = (unsigned)(int)__builtin_rintf(bf_hi(w[j].x) * inv) & 0xffu, b2 = (unsigned)(int)__builtin_rintf(bf_lo(w[j].y) * inv) & 0xffu, b3 = (unsigned)(int)__builtin_rintf(bf_hi(w[j].y) * inv) & 0xffu;
        const unsigned b4 = (unsigned)(int)__builtin_rintf(bf_lo(w[j].z) * inv) & 0xffu, b5 = (unsigned)(int)__builtin_rintf(bf_hi(w[j].z) * inv) & 0xffu, b6 = (unsigned)(int)__builtin_rintf(bf_lo(w[j].w) * inv) & 0xffu, b7 = (unsigned)(int)__builtin_rintf(bf_hi(w[j].w) * inv) & 0xffu;
        u32x2 o; o.x = b0 | (b1 << 8) | (b2 << 16) | (b3 << 24); o.y = b4 | (b5 << 8) | (b6 << 16) | (b7 << 24);
        *(u32x2*)(qrow + (size_t)(j * 64 + lane) * 8) = o; }
    if (lane == 0) *sa = mx * (1.0f / 127.0f);
}

__device__ __forceinline__ void quant_rows(const bf16_t* X, unsigned char* Q, float* SA, int r0, int r1, int w, int NW, int lane) {
    int r = r0 + w; if (r >= r1) return;
    u32x4 cw[8]; quant_row_load(X + (size_t)r * D, cw, lane);
    for (;;) { const int nx = r + NW; const bool more = nx < r1; u32x4 nw[8];
        if (more) quant_row_load(X + (size_t)nx * D, nw, lane);
        quant_row_finish(cw, Q + (size_t)r * D, SA + r, lane);
        if (!more) break;
#pragma unroll
        for (int j = 0; j < 8; ++j) cw[j] = nw[j];
        r = nx; }
}

__device__ __forceinline__ void p0_prologue(Frame& F) {
    const int gw = F.bid * NWAVES + F.wave, NGW = F.G * NWAVES;
    unsigned char* ws = F.ws;
    convert_items(F, 0, NIT_P0, gw, NGW);
    q8_colmax(F, 0, NIT_Q8, gw, NGW);
    bf16_t* XB = (bf16_t*)(ws + WS_XB); bf16_t* MEMB = (bf16_t*)(ws + WS_MEMB);
    for (int m = gw; m < M + NB * NMEM; m += NGW) {
        if (m < MP) norm_row_to_bf16(F.in[I_XP] + (size_t)m * D, F.in[I_NMIX], XB + (size_t)m * D, F.lane, ws + WS_XBQ + (size_t)m * D, (float*)(ws + WS_SAI) + m);
        else if (m < M) norm_row_to_bf16(F.in[I_XS] + (size_t)(m - MP) * D, F.in[I_NMIX], XB + (size_t)m * D, F.lane, ws + WS_XBQ + (size_t)m * D, (float*)(ws + WS_SAI) + m);
        else norm_row_to_bf16(F.in[I_MEM] + (size_t)(m - M) * D, F.in[I_NMEM], MEMB + (size_t)(m - M) * D, F.lane);
    }
    { const f32x4* src = (const f32x4*)F.in[I_CK]; u32x2* dst = (u32x2*)(ws + WS_MKS); constexpr size_t n4 = (size_t)DECB * NMEM * D / 4;
      static_assert(n4 % 2048 == 0, "batch");
      for (size_t blk = F.bid; blk < n4 / 2048; blk += F.G) { const size_t i = blk * 2048 + F.tid; f32x4 v[4];
#pragma unroll
          for (int q = 0; q < 4; ++q) v[q] = src[i + q * 512];
#pragma unroll
          for (int q = 0; q < 4; ++q) { u32x2 w; w.x = pk2(v[q].x, v[q].y); w.y = pk2(v[q].z, v[q].w); dst[i + q * 512] = w; } } }
    { const f32x4* src = (const f32x4*)F.in[I_WXQ]; u32x2* dst = (u32x2*)(ws + WS_WXQRM); const float* gx = F.in[I_NXA]; constexpr size_t n4 = (size_t)D * D / 4;
      static_assert(n4 % 2048 == 0, "batch");
      for (size_t blk = F.bid; blk < n4 / 2048; blk += F.G) { const size_t i = blk * 2048 + F.tid; f32x4 v[4]; float g[4];
#pragma unroll
          for (int q = 0; q < 4; ++q) { v[q] = src[i + q * 512]; g[q] = gx[(i + q * 512) >> 10]; }
#pragma unroll
          for (int q = 0; q < 4; ++q) { const f32x4 x = v[q] * g[q]; u32x2 w; w.x = pk2(x.x, x.y); w.y = pk2(x.z, x.w); dst[i + q * 512] = w; } } }
    { float* LB = (float*)(ws + WS_LB); const float* l = F.in[I_LBL];
      for (int i = F.bid * 512 + F.tid; i < HGW; i += F.G * 512) { const float a = l[i], b = l[HGW + i], mx = fmaxf(a, b), ea = expf(a - mx), eb = expf(b - mx); LB[i] = ea / (ea + eb); } }
}

__device__ __forceinline__ void st_bf16x8(bf16_t* p, const f32x4 a, const f32x4 b) { u32x4 w; w.x = cvt_pk_bf16(a[0], a[1]); w.y = cvt_pk_bf16(a[2], a[3]); w.z = cvt_pk_bf16(b[0], b[1]); w.w = cvt_pk_bf16(b[2], b[3]); *(u32x4*)p = w; }

template <int ACT> __device__ __forceinline__ void act8_tiles(const Acc& acc, bf16_t* PROJ, int row0, int col, const float (&rsv)[8], const f32x2 (&sb)[2][4]) {
    const f32x2 c1 = (f32x2){-1.44269504089f, -1.44269504089f}, one = (f32x2){1.0f, 1.0f};
#pragma unroll
    for (int ai = 0; ai < 2; ++ai)
#pragma unroll
        for (int m = 0; m < 4; ++m) { const int row = row0 + ai * 128 + m * 16; const float rf = rsv[ai * 4 + m]; const f32x2 rf2 = (f32x2){rf, rf};
#pragma unroll
            for (int bj = 0; bj < 2; ++bj) { f32x4 o[2];
#pragma unroll
                for (int n = 0; n < 2; ++n) { const i32x4 xi = __builtin_bit_cast(i32x4, acc[ai][bj][m][n]);
#pragma unroll
                    for (int j = 0; j < 4; j += 2) { const f32x2 x = ((f32x2){(float)xi[j], (float)xi[j + 1]} * sb[bj][2 * n + (j >> 1)]) * rf2; f32x2 r = x;
                        if constexpr (ACT != 0) { const f32x2 e = c1 * x; f32x2 t; t.x = fast_exp2(e.x); t.y = fast_exp2(e.y);
                            const f32x2 d = t + one; r.x = fast_rcp(d.x); r.y = fast_rcp(d.y); if constexpr (ACT == 1) r = x * r; }
                        o[n][j] = r.x; o[n][j + 1] = r.y; } }
                st_bf16x8(PROJ + (size_t)row * PW + col + bj * 128, o[0], o[1]); } }
}

struct P1Prob {
    static constexpr bool HAS_MID = false; static constexpr bool I8 = false;
    const char *A, *B, *A2, *B2; unsigned lda, ldb; int nt, G, c;
    bf16_t* PROJ; float* LOGF; const float* LB; float* out; bf16_t* MKB; bf16_t* MVB;
    int nsc, R;
    __device__ __forceinline__ bool next(int i, Unit& u) const {
        long L; constexpr int N0 = 65 * 32;
        if (nsc == 0) L = (long)i * G + c;
        else { const int Gp = G - nsc; if (c >= nsc) L = (i < R) ? (long)i * Gp + (c - nsc) : (long)R * Gp + (long)(i - R) * G + c; else L = (long)R * Gp + (long)i * G + c; }
        if (L < N0) { pg8::static_unit((int)L, 65, 32, u); u.z = 0; return true; }
        if (L < N0 + 64) { const int l = (int)L - N0; u.z = 1; u.pm = l >> 5; u.pn = l & 31; return true; }
        return false;
    }
    __device__ __forceinline__ const char* a_ptr(const Unit& u) const { return (u.z ? A2 : A) + (size_t)u.pm * 256 * lda; }
    __device__ __forceinline__ const char* b_ptr(const Unit& u) const { return (u.z ? B2 : B) + (size_t)u.pn * 256 * ldb; }
    __device__ __forceinline__ void mid(Acc&, const Unit&, int, int, int, int) const {}
    __device__ __forceinline__ void epi(Acc& acc, const Unit& u, int wr, int wc, int fr, int fq, int, int) const {
        const int row0 = u.pm * 256 + wr * 64 + fr, cl = wc * 32 + 8 * fq;
        if (u.z) {
            const bool isv = u.pn >= 16; const int colt = (u.pn & 15) * 256; float* o = out + (isv ? O_MV : O_MK);
#pragma unroll
            for (int ai = 0; ai < 2; ++ai)
#pragma unroll
                for (int m = 0; m < 4; ++m) { const int row = row0 + ai * 128 + m * 16;
#pragma unroll
                    for (int bj = 0; bj < 2; ++bj) { const int col = colt + bj * 128 + cl; const f32x4 v0 = acc[ai][bj][m][0], v1 = acc[ai][bj][m][1];
                        *(f32x4*)(o + (size_t)row * D + col) = v0; *(f32x4*)(o + (size_t)row * D + col + 4) = v1;
                        st_bf16x8((isv ? MVB : MKB) + (size_t)row * D + col, v0, v1); } }
            return;
        }
        const int pn = u.pn;
        if (pn >= 24) {
            const int colt = (pn - 24) * 256;
            f32x4 lb[2][2];
#pragma unroll
            for (int bj = 0; bj < 2; ++bj) { lb[bj][0] = *(const f32x4*)(LB + colt + bj * 128 + cl); lb[bj][1] = *(const f32x4*)(LB + colt + bj * 128 + cl + 4); }
#pragma unroll
            for (int ai = 0; ai < 2; ++ai)
#pragma unroll
                for (int m = 0; m < 4; ++m) { const int row = row0 + ai * 128 + m * 16;
#pragma unroll
                    for (int bj = 0; bj < 2; ++bj)
#pragma unroll
                        for (int n = 0; n < 2; ++n) { f32x4 o;
#pragma unroll
                            for (int j = 0; j < 4; ++j) { const float l = lb[bj][n][j]; o[j] = __log2f(l + (1.0f - l) * sigmoid_f(acc[ai][bj][m][n][j])); }
                            *(f32x4*)(LOGF + (size_t)row * HGW + colt + bj * 128 + cl + 4 * n) = o; } }
            return;
        }
        if (pn < 16) {
            const int colu = PC_U + pn * 128 + cl;
#pragma unroll
            for (int ai = 0; ai < 2; ++ai)
#pragma unroll
                for (int m = 0; m < 4; ++m) { const int row = row0 + ai * 128 + m * 16;
                    const f32x4 u0 = acc[ai][0][m][0] * acc[ai][1][m][0], u1 = acc[ai][0][m][1] * acc[ai][1][m][1];
                    st_bf16x8(PROJ + (size_t)row * PW + colu, u0, u1);
                    int seq, t, L; if (row < MP) { seq = row >> 13; t = row & (SEQ - 1); L = SEQ; } else { seq = (row - MP) >> 5; t = (row - MP) & 31; L = DECS; }
                    if (t >= L - 2) { float* o = (row < MP ? out + O_CP : out + O_CS) + ((size_t)seq * 2 + (t - (L - 2))) * CW + pn * 128 + cl;
                        *(f32x4*)o = u0; *(f32x4*)(o + 4) = u1; } }
            return;
        }
        const int colt = PC_IV + (pn - 16) * 256;
#pragma unroll
        for (int ai = 0; ai < 2; ++ai)
#pragma unroll
            for (int m = 0; m < 4; ++m) { const int row = row0 + ai * 128 + m * 16;
#pragma unroll
                for (int bj = 0; bj < 2; ++bj) st_bf16x8(PROJ + (size_t)row * PW + colt + bj * 128 + cl, acc[ai][bj][m][0], acc[ai][bj][m][1]); }
    }
};

struct GemmBase {
    const char *A, *B; unsigned lda, ldb; int nt, G, c, nM, nN, pm0;
    __device__ __forceinline__ bool next(int i, Unit& u) const { const long L = (long)i * G + c; if (L >= (long)nM * nN) return false; pg8::static_unit((int)L, nM, nN, u); u.pm += pm0; u.z = 0; return true; }
    __device__ __forceinline__ const char* a_ptr(const Unit& u) const { return A + (size_t)u.pm * 256 * lda; }
    __device__ __forceinline__ const char* b_ptr(const Unit& u) const { return B + (size_t)u.pn * 256 * ldb; }
};

struct P1bProb : GemmBase {
    static constexpr bool HAS_MID = false; static constexpr bool I8 = true;
    const float* SA; const float* SB; bf16_t* PROJ; LAS float* rsc; mutable int rsc_pm;
    __device__ __forceinline__ void mid(Acc&, const Unit&, int, int, int, int) const {}
    __device__ __forceinline__ void epi(Acc& acc, const Unit& u, int wr, int wc, int fr, int fq, int, int) const {
        const int row0 = u.pm * 256 + wr * 64 + fr, cl = wc * 32 + 8 * fq, bc0 = u.pn * 256 + cl;
        float rsv[8];
        if (rsc_pm != u.pm) {
#pragma unroll
            for (int q = 0; q < 8; ++q) rsv[q] = SA[row0 + (q >> 2) * 128 + (q & 3) * 16];
            *(LAS f32x4*)rsc = (f32x4){rsv[0], rsv[1], rsv[2], rsv[3]}; *(LAS f32x4*)(rsc + 4) = (f32x4){rsv[4], rsv[5], rsv[6], rsv[7]}; rsc_pm = u.pm;
        } else { const f32x4 a = *(const LAS f32x4*)rsc, b = *(const LAS f32x4*)(rsc + 4); rsv[0] = a[0]; rsv[1] = a[1]; rsv[2] = a[2]; rsv[3] = a[3]; rsv[4] = b[0]; rsv[5] = b[1]; rsv[6] = b[2]; rsv[7] = b[3]; }
        const f32x4 s00 = *(const f32x4*)(SB + bc0), s01 = *(const f32x4*)(SB + bc0 + 4), s10 = *(const f32x4*)(SB + bc0 + 128), s11 = *(const f32x4*)(SB + bc0 + 132);
        const f32x2 sb[2][4] = {{(f32x2){s00[0], s00[1]}, (f32x2){s00[2], s00[3]}, (f32x2){s01[0], s01[1]}, (f32x2){s01[2], s01[3]}}, {(f32x2){s10[0], s10[1]}, (f32x2){s10[2], s10[3]}, (f32x2){s11[0], s11[1]}, (f32x2){s11[2], s11[3]}}};
        const int pn = u.pn;
        if (pn < 8) act8_tiles<0>(acc, PROJ, row0, PC_CB + pn * 256 + cl, rsv, sb);
        else if (pn < 16) act8_tiles<1>(acc, PROJ, row0, PC_OG + (pn - 8) * 256 + cl, rsv, sb);
        else if (pn < 32) act8_tiles<2>(acc, PROJ, row0, PC_GA + (pn - 16) * 256 + cl, rsv, sb);
        else if (pn < 48) act8_tiles<2>(acc, PROJ, row0, PC_GB + (pn - 32) * 256 + cl, rsv, sb);
        else act8_tiles<0>(acc, PROJ, row0, PC_Q + (pn - 48) * 256 + cl, rsv, sb);
    }
};

struct P5Prob : GemmBase {
    static constexpr bool HAS_MID = true; static constexpr bool I8 = false;
    const bf16_t* PROJ; bf16_t* OUT;
    __device__ __forceinline__ void mid(Acc& acc, const Unit& u, int wr, int wc, int, int) const {
        int lz = threadIdx.x & 63; asm volatile("" : "+v"(lz));
        const int fr = lz & 15, fq = lz >> 4;
        const int row0 = u.pm * 256 + wr * 64 + fr, col0 = u.pn * 256 + wc * 32 + 8 * fq;
#pragma unroll
        for (int ai = 0; ai < 2; ++ai) {
#pragma unroll
            for (int m = 0; m < 4; ++m) { const bf16_t* rp = PROJ + (size_t)(row0 + ai * 128 + m * 16) * PW + col0;
#pragma unroll
                for (int bj = 0; bj < 2; ++bj) { const u32x4 ga = *(const u32x4*)(rp + PC_GA + bj * 128), gb = *(const u32x4*)(rp + PC_GB + bj * 128);
                    f32x4 r0, r1;
                    r0[0] = bf_lo(ga.x) * fast_rcp(fmaxf(bf_lo(gb.x), 1e-30f)); r0[1] = bf_hi(ga.x) * fast_rcp(fmaxf(bf_hi(gb.x), 1e-30f)); r0[2] = bf_lo(ga.y) * fast_rcp(fmaxf(bf_lo(gb.y), 1e-30f)); r0[3] = bf_hi(ga.y) * fast_rcp(fmaxf(bf_hi(gb.y), 1e-30f));
                    r1[0] = bf_lo(ga.z) * fast_rcp(fmaxf(bf_lo(gb.z), 1e-30f)); r1[1] = bf_hi(ga.z) * fast_rcp(fmaxf(bf_hi(gb.z), 1e-30f)); r1[2] = bf_lo(ga.w) * fast_rcp(fmaxf(bf_lo(gb.w), 1e-30f)); r1[3] = bf_hi(ga.w) * fast_rcp(fmaxf(bf_hi(gb.w), 1e-30f));
                    acc[ai][bj][m][0] *= r0; acc[ai][bj][m][1] *= r1; }
                if (m & 1) asm volatile("" ::: "memory"); } }
    }
    __device__ __forceinline__ void epi(Acc& acc, const Unit& u, int wr, int wc, int fr, int fq, int, int) const {
        const int row0 = u.pm * 256 + wr * 64 + fr, col0 = u.pn * 256 + wc * 32 + 8 * fq;
#pragma unroll
        for (int ai = 0; ai < 2; ++ai) {
#pragma unroll
            for (int m = 0; m < 4; ++m) { const int row = row0 + ai * 128 + m * 16; const bf16_t* rp = PROJ + (size_t)row * PW + col0;
#pragma unroll
                for (int bj = 0; bj < 2; ++bj) { const u32x4 gb = *(const u32x4*)(rp + PC_GB + bj * 128);
                    f32x4 v0 = acc[ai][bj][m][0], v1 = acc[ai][bj][m][1];
                    v0[0] *= bf_lo(gb.x); v0[1] *= bf_hi(gb.x); v0[2] *= bf_lo(gb.y); v0[3] *= bf_hi(gb.y); v1[0] *= bf_lo(gb.z); v1[1] *= bf_hi(gb.z); v1[2] *= bf_lo(gb.w); v1[3] *= bf_hi(gb.w);
                    st_bf16x8(OUT + (size_t)row * D + col0 + bj * 128, v0, v1); } }
            asm volatile("" ::: "memory"); }
    }
};

template <bool RES_F32, bool Q8 = false> struct ResProb : GemmBase {
    static constexpr bool HAS_MID = false; static constexpr bool I8 = Q8;
    const float* resP; const float* resS;
    bf16_t* XB; float* SS; const float* SA; const float* SB; LAS float* rsc; mutable int rsc_pm;
    __device__ __forceinline__ void mid(Acc&, const Unit&, int, int, int, int) const {}
    __device__ __forceinline__ void epi(Acc& acc, const Unit& u, int wr, int wc, int fr, int fq, int, int) const {
        const int row0 = u.pm * 256 + wr * 64 + fr, col0 = u.pn * 256 + wc * 32 + 8 * fq;
        const float* res = (u.pm < MP / 256) ? resP : resS - (size_t)MP * D;
        float rsv[8]; f32x4 sbv[2][2];
        if constexpr (Q8) {
            if (rsc_pm != u.pm) {
#pragma unroll
                for (int q = 0; q < 8; ++q) rsv[q] = SA[row0 + (q >> 2) * 128 + (q & 3) * 16];
                *(LAS f32x4*)rsc = (f32x4){rsv[0], rsv[1], rsv[2], rsv[3]}; *(LAS f32x4*)(rsc + 4) = (f32x4){rsv[4], rsv[5], rsv[6], rsv[7]}; rsc_pm = u.pm;
            } else { const f32x4 a = *(const LAS f32x4*)rsc, b = *(const LAS f32x4*)(rsc + 4); rsv[0] = a[0]; rsv[1] = a[1]; rsv[2] = a[2]; rsv[3] = a[3]; rsv[4] = b[0]; rsv[5] = b[1]; rsv[6] = b[2]; rsv[7] = b[3]; }
#pragma unroll
            for (int bj = 0; bj < 2; ++bj) { sbv[bj][0] = *(const f32x4*)(SB + col0 + bj * 128); sbv[bj][1] = *(const f32x4*)(SB + col0 + bj * 128 + 4); }
        }
#pragma unroll
        for (int ai = 0; ai < 2; ++ai)
#pragma unroll
            for (int m = 0; m < 4; ++m) { const int row = row0 + ai * 128 + m * 16; float ss = 0.f;
#pragma unroll
                for (int bj = 0; bj < 2; ++bj) { const size_t off = (size_t)row * D + col0 + bj * 128;
                    f32x4 a0, a1;
                    if constexpr (Q8) { const i32x4 i0 = __builtin_bit_cast(i32x4, acc[ai][bj][m][0]), i1 = __builtin_bit_cast(i32x4, acc[ai][bj][m][1]); const float rf = rsv[ai * 4 + m];
                        a0 = (f32x4){(float)i0[0], (float)i0[1], (float)i0[2], (float)i0[3]} * sbv[bj][0] * rf; a1 = (f32x4){(float)i1[0], (float)i1[1], (float)i1[2], (float)i1[3]} * sbv[bj][1] * rf; }
                    else { a0 = acc[ai][bj][m][0]; a1 = acc[ai][bj][m][1]; }
                    f32x4 x0, x1;
                    if constexpr (RES_F32) { x0 = *(const f32x4*)(res + off) + a0; x1 = *(const f32x4*)(res + off + 4) + a1; }
                    else { const u32x4 rw = *(const u32x4*)(XB + off);
                        x0 = (f32x4){bf_lo(rw.x), bf_hi(rw.x), bf_lo(rw.y), bf_hi(rw.y)} + a0; x1 = (f32x4){bf_lo(rw.z), bf_hi(rw.z), bf_lo(rw.w), bf_hi(rw.w)} + a1; }
                    st_bf16x8(XB + off, x0, x1);
                    ss += (x0[0] * x0[0] + x0[1] * x0[1]) + (x0[2] * x0[2] + x0[3] * x0[3]) + (x1[0] * x1[0] + x1[1] * x1[1]) + (x1[2] * x1[2] + x1[3] * x1[3]); }
                ss += __shfl_xor(ss, 16); ss += __shfl_xor(ss, 32);
                if (fq == 0) unsafeAtomicAdd(SS + row, ss);
                if (m == 3) asm volatile("" ::: "memory"); }
    }
};
struct P10sProb : ResProb<false, false> {
    __device__ __forceinline__ const char* b_ptr(const Unit& u) const { return B + ((size_t)(u.pm >> 5) * D + (size_t)u.pn * 256) * ldb; }
};

struct P7Prob : GemmBase {
    static constexpr bool HAS_MID = false; static constexpr bool I8 = true;
    const float* SS; const float* SA; const float* SB; bf16_t* OUT; LAS float* rsc; mutable int rsc_pm;
    __device__ __forceinline__ void mid(Acc&, const Unit&, int, int, int, int) const {}
    __device__ __forceinline__ void epi(Acc& acc, const Unit& u, int wr, int wc, int fr, int fq, int, int) const {
        const int row0 = u.pm * 256 + wr * 64 + fr, col0 = u.pn * 256 + wc * 32 + 8 * fq;
        float rsv[8];
        if (rsc_pm != u.pm) {
#pragma unroll
            for (int q = 0; q < 8; ++q) { const int row = row0 + (q >> 2) * 128 + (q & 3) * 16; rsv[q] = SA[row] * (1.0f / sqrtf(SS[row] * (1.0f / D) + EPS)) * (1.44269504089f / 32.0f); }
            *(LAS f32x4*)rsc = (f32x4){rsv[0], rsv[1], rsv[2], rsv[3]}; *(LAS f32x4*)(rsc + 4) = (f32x4){rsv[4], rsv[5], rsv[6], rsv[7]}; rsc_pm = u.pm;
        } else { const f32x4 a = *(const LAS f32x4*)rsc, b = *(const LAS f32x4*)(rsc + 4); rsv[0] = a[0]; rsv[1] = a[1]; rsv[2] = a[2]; rsv[3] = a[3]; rsv[4] = b[0]; rsv[5] = b[1]; rsv[6] = b[2]; rsv[7] = b[3]; }
        f32x4 sbv[2][2];
#pragma unroll
        for (int bj = 0; bj < 2; ++bj) { sbv[bj][0] = *(const f32x4*)(SB + col0 + bj * 128); sbv[bj][1] = *(const f32x4*)(SB + col0 + bj * 128 + 4); }
#pragma unroll
        for (int ai = 0; ai < 2; ++ai)
#pragma unroll
            for (int m = 0; m < 4; ++m) { const int row = row0 + ai * 128 + m * 16; const float sc = rsv[ai * 4 + m];
#pragma unroll
                for (int bj = 0; bj < 2; ++bj) { const i32x4 i0 = __builtin_bit_cast(i32x4, acc[ai][bj][m][0]), i1 = __builtin_bit_cast(i32x4, acc[ai][bj][m][1]);
                    st_bf16x8(OUT + (size_t)row * D + col0 + bj * 128, (f32x4){(float)i0[0], (float)i0[1], (float)i0[2], (float)i0[3]} * sbv[bj][0] * sc, (f32x4){(float)i1[0], (float)i1[1], (float)i1[2], (float)i1[3]} * sbv[bj][1] * sc); } }
    }
};

struct PreProb {
    static constexpr bool HAS_MID = false; static constexpr bool I8 = false;
    const char *MKB, *MVB, *WXQRM, *WXOT; bf16_t *WPT, *VP; unsigned lda, ldb; int nt, G, c;
    __device__ __forceinline__ void pre(const Unit&, int) const {}
    __device__ __forceinline__ bool next(int i, Unit& u) const { const long L = (long)i * G + c; if (L >= 256) return false; u.z = (int)L >> 7; u.pm = ((int)L & 127) >> 4; u.pn = (int)L & 15; return true; }
    __device__ __forceinline__ const char* a_ptr(const Unit& u) const { const int b = u.pm >> 2, h = u.pm & 3;
        return u.z == 0 ? MKB + (size_t)b * NMEM * lda + (size_t)h * XD * 2 : WXOT + (size_t)u.pn * 256 * lda + (size_t)h * XD * 2; }
    __device__ __forceinline__ const char* b_ptr(const Unit& u) const { const int b = u.pm >> 2, h = u.pm & 3;
        return u.z == 0 ? WXQRM + (size_t)u.pn * 256 * ldb + (size_t)h * XD * 2 : MVB + (size_t)b * NMEM * ldb + (size_t)h * XD * 2; }
    __device__ __forceinline__ void mid(Acc&, const Unit&, int, int, int, int) const {}
    __device__ __forceinline__ void epi(Acc& acc, const Unit& u, int wr, int wc, int fr, int fq, int, int) const {
        const int rl0 = wr * 64 + fr, cl = wc * 32 + 8 * fq, b = u.pm >> 2, h = u.pm & 3;
        bf16_t* base; size_t ld;
        if (u.z == 0) { base = WPT + (size_t)u.pm * NMEM * D + (size_t)u.pn * 256; ld = D; }
        else { base = VP + ((size_t)b * D + (size_t)u.pn * 256) * (XH * NMEM) + (size_t)h * NMEM; ld = XH * NMEM; }
#pragma unroll
        for (int ai = 0; ai < 2; ++ai)
#pragma unroll
            for (int m = 0; m < 4; ++m) { const int rl = rl0 + ai * 128 + m * 16;
#pragma unroll
                for (int bj = 0; bj < 2; ++bj) st_bf16x8(base + (size_t)rl * ld + bj * 128 + cl, acc[ai][bj][m][0], acc[ai][bj][m][1]); }
    }
};

struct P7sProb {
    static constexpr bool HAS_MID = false; static constexpr bool I8 = false;
    const char *X1, *WPT; unsigned lda, ldb; int nt, G, c; const float* SS; bf16_t* PB; LAS float* ldsx;
    __device__ __forceinline__ void pre(const Unit&, int) const {}
    __device__ __forceinline__ bool next(int i, Unit& u) const { const long L = (long)i * G + c; if (L >= 256) return false; const int x = (int)L & 7, j = (int)L >> 3; u.pm = 8 * x + (j >> 2); u.pn = j & 3; u.z = 0; return true; }
    __device__ __forceinline__ const char* a_ptr(const Unit& u) const { return X1 + (size_t)u.pm * 256 * lda; }
    __device__ __forceinline__ const char* b_ptr(const Unit& u) const { return WPT + (size_t)((u.pm >> 5) * 4 + u.pn) * NMEM * ldb; }
    __device__ __forceinline__ void mid(Acc&, const Unit&, int, int, int, int) const {}
    __device__ __forceinline__ void epi(Acc& acc, const Unit& u, int wr, int wc, int fr, int fq, int, int) const {
        const int rl0 = wr * 64 + fr;
#pragma unroll
        for (int ai = 0; ai < 2; ++ai)
#pragma unroll
            for (int m = 0; m < 4; ++m) { const int rl = rl0 + ai * 128 + m * 16; const float sc = (1.0f / sqrtf(SS[u.pm * 256 + rl] * (1.0f / D) + EPS)) * (1.44269504089f / 32.0f);
                float v = -3.0e38f;
#pragma unroll
                for (int bj = 0; bj < 2; ++bj)
#pragma unroll
                    for (int n = 0; n < 2; ++n) { const f32x4 x = acc[ai][bj][m][n] * sc; acc[ai][bj][m][n] = x; v = fmaxf(v, fmaxf(fmaxf(x[0], x[1]), fmaxf(x[2], x[3]))); }
                v = fmaxf(v, __shfl_xor(v, 16)); v = fmaxf(v, __shfl_xor(v, 32));
                if (fq == 0) ldsx[rl * 4 + wc] = v; }
        LDS_WAIT(); __builtin_amdgcn_s_barrier(); asm volatile("" ::: "memory");
#pragma unroll
        for (int ai = 0; ai < 2; ++ai)
#pragma unroll
            for (int m = 0; m < 4; ++m) { const int rl = rl0 + ai * 128 + m * 16; const f32x4 q = *(const LAS f32x4*)(ldsx + rl * 4); const float mx = fmaxf(fmaxf(q[0], q[1]), fmaxf(q[2], q[3])); float sm = 0.f;
#pragma unroll
                for (int bj = 0; bj < 2; ++bj)
#pragma unroll
                    for (int n = 0; n < 2; ++n) { f32x4 p;
#pragma unroll
                        for (int j = 0; j < 4; ++j) p[j] = fast_exp2(acc[ai][bj][m][n][j] - mx);
                        acc[ai][bj][m][n] = p; sm += (p[0] + p[1]) + (p[2] + p[3]); }
                sm += __shfl_xor(sm, 16); sm += __shfl_xor(sm, 32);
                if (fq == 0) ldsx[1024 + rl * 4 + wc] = sm; }
        LDS_WAIT(); __builtin_amdgcn_s_barrier(); asm volatile("" ::: "memory");
        int lz = threadIdx.x & 63; asm volatile("" : "+v"(lz));
        const int rz0 = wr * 64 + (lz & 15), cz = u.pn * NMEM + wc * 32 + 8 * (lz >> 4);
#pragma unroll
        for (int ai = 0; ai < 2; ++ai)
#pragma unroll
            for (int m = 0; m < 4; ++m) { const int rl = rz0 + ai * 128 + m * 16; const f32x4 q = *(const LAS f32x4*)(ldsx + 1024 + rl * 4); const float inv = 1.0f / ((q[0] + q[1]) + (q[2] + q[3]));
#pragma unroll
                for (int bj = 0; bj < 2; ++bj) st_bf16x8(PB + (size_t)(u.pm * 256 + rl) * (XH * NMEM) + cz + bj * 128, acc[ai][bj][m][0] * inv, acc[ai][bj][m][1] * inv); }
        LDS_WAIT(); __builtin_amdgcn_s_barrier(); asm volatile("" ::: "memory");
    }
};

struct P8Prob {
    static constexpr bool HAS_MID = false; static constexpr bool I8 = false;
    const char *QX, *MKB, *MKS; unsigned lda, ldb; int nt, G, c, L0, LN;
    bf16_t* PB; float* LSUM; LAS float* ldsx;
    __device__ __forceinline__ bool next(int i, Unit& u) const { long L = (long)i * G + c; if (L >= LN) return false; L += L0;
        if (L < 256) { u.pm = (int)L >> 2; u.pn = (int)L & 3; u.z = -1; } else { const int l = (int)L - 256; u.pm = 64; u.pn = l & 3; u.z = l >> 2; } return true; }
    __device__ __forceinline__ const char* a_ptr(const Unit& u) const { return QX + (size_t)u.pm * 256 * lda + (size_t)u.pn * XD * 2; }
    __device__ __forceinline__ const char* b_ptr(const Unit& u) const { return (u.z < 0 ? MKB + (size_t)(u.pm >> 5) * NMEM * ldb : MKS + (size_t)u.z * NMEM * ldb) + (size_t)u.pn * XD * 2; }
    __device__ __forceinline__ void mid(Acc&, const Unit&, int, int, int, int) const {}
    __device__ __forceinline__ void epi(Acc& acc, const Unit& u, int wr, int wc, int fr, int fq, int, int) const {
        const int rl0 = wr * 64 + fr;
        float mx[2][4];
#pragma unroll
        for (int ai = 0; ai < 2; ++ai)
#pragma unroll
            for (int m = 0; m < 4; ++m) { float v = -3.0e38f;
#pragma unroll
                for (int bj = 0; bj < 2; ++bj)
#pragma unroll
                    for (int n = 0; n < 2; ++n) { const f32x4 x = acc[ai][bj][m][n]; v = fmaxf(v, fmaxf(fmaxf(x[0], x[1]), fmaxf(x[2], x[3]))); }
                v = fmaxf(v, __shfl_xor(v, 16)); v = fmaxf(v, __shfl_xor(v, 32));
                if (fq == 0) ldsx[(rl0 + ai * 128 + m * 16) * 4 + wc] = v; }
        LDS_WAIT(); __builtin_amdgcn_s_barrier(); asm volatile("" ::: "memory");
#pragma unroll
        for (int ai = 0; ai < 2; ++ai)
#pragma unroll
            for (int m = 0; m < 4; ++m) { const f32x4 q = *(const LAS f32x4*)(ldsx + (rl0 + ai * 128 + m * 16) * 4); mx[ai][m] = fmaxf(fmaxf(q[0], q[1]), fmaxf(q[2], q[3])); }
        LDS_WAIT(); __builtin_amdgcn_s_barrier(); asm volatile("" ::: "memory");
#pragma unroll
        for (int ai = 0; ai < 2; ++ai)
#pragma unroll
            for (int m = 0; m < 4; ++m) { const int rl = rl0 + ai * 128 + m * 16, row = u.pm * 256 + rl; float s = 0.f;
                const bool ok = (u.z < 0) || ((rl >> 5) == u.z);
#pragma unroll
                for (int bj = 0; bj < 2; ++bj) { f32x4 p0, p1;
#pragma unroll
                    for (int j = 0; j < 4; ++j) { p0[j] = fast_exp2(acc[ai][bj][m][0][j] - mx[ai][m]); p1[j] = fast_exp2(acc[ai][bj][m][1][j] - mx[ai][m]); }
                    s += (p0[0] + p0[1]) + (p0[2] + p0[3]) + (p1[0] + p1[1]) + (p1[2] + p1[3]);
                    if (ok) st_bf16x8(PB + (size_t)row * 1024 + u.pn * 256 + bj * 128 + wc * 32 + 8 * fq, p0, p1); }
                s += __shfl_xor(s, 16); s += __shfl_xor(s, 32);
                if (fq == 0 && ok) LSUM[((size_t)row * 4 + u.pn) * 4 + wc] = s; }
    }
};

struct P9Prob {
    static constexpr bool HAS_MID = false; static constexpr bool I8 = false;
    const char *PB, *MVT, *VTS; unsigned lda, ldb; int nt, G, c, L0, LN;
    const float* LSUM; bf16_t* OX; LAS float* rsc; mutable int rsc_key;
    __device__ __forceinline__ bool next(int i, Unit& u) const { long L = (long)i * G + c; if (L >= LN) return false; L += L0;
        if (L < 1024) { const int cc = (int)L & 255, ii = (int)L >> 8; u.pm = cc >> 2; u.pn = (cc & 3) * 4 + ii; u.z = -1; } else { const int l = (int)L - 1024; u.pm = 64; u.pn = l & 15; u.z = l >> 4; } return true; }
    __device__ __forceinline__ const char* a_ptr(const Unit& u) const { return PB + (size_t)u.pm * 256 * lda + (size_t)(u.pn >> 2) * NMEM * 2; }
    __device__ __forceinline__ const char* b_ptr(const Unit& u) const { return (u.z < 0 ? MVT + (size_t)(u.pm >> 5) * D * ldb : VTS + (size_t)u.z * D * ldb) + (size_t)u.pn * 256 * ldb; }
    __device__ __forceinline__ void mid(Acc&, const Unit&, int, int, int, int) const {}
    __device__ __forceinline__ void epi(Acc& acc, const Unit& u, int wr, int wc, int fr, int fq, int, int) const {
        const int rl0 = wr * 64 + fr, col0 = u.pn * 256 + wc * 32 + 8 * fq, h = u.pn >> 2;
        float iv[8]; const int key = u.pm * 4 + h;
        if (rsc_key != key) {
#pragma unroll
            for (int q = 0; q < 8; ++q) { const f32x4 l4 = *(const f32x4*)(LSUM + ((size_t)(u.pm * 256 + rl0 + (q >> 2) * 128 + (q & 3) * 16) * 4 + h) * 4); iv[q] = 1.0f / ((l4[0] + l4[1]) + (l4[2] + l4[3])); }
            *(LAS f32x4*)rsc = (f32x4){iv[0], iv[1], iv[2], iv[3]}; *(LAS f32x4*)(rsc + 4) = (f32x4){iv[4], iv[5], iv[6], iv[7]}; rsc_key = key;
        } else { const f32x4 a = *(const LAS f32x4*)rsc, b = *(const LAS f32x4*)(rsc + 4); iv[0] = a[0]; iv[1] = a[1]; iv[2] = a[2]; iv[3] = a[3]; iv[4] = b[0]; iv[5] = b[1]; iv[6] = b[2]; iv[7] = b[3]; }
#pragma unroll
        for (int ai = 0; ai < 2; ++ai)
#pragma unroll
            for (int m = 0; m < 4; ++m) { const int rl = rl0 + ai * 128 + m * 16, row = u.pm * 256 + rl;
                const bool ok = (u.z < 0) || ((rl >> 5) == u.z);
                if (ok) { const float inv = iv[ai * 4 + m];
#pragma unroll
                    for (int bj = 0; bj < 2; ++bj) st_bf16x8(OX + (size_t)row * D + col0 + bj * 128, acc[ai][bj][m][0] * inv, acc[ai][bj][m][1] * inv); } }
    }
};

struct P11Prob : GemmBase {
    static constexpr bool HAS_MID = false; static constexpr bool I8 = true;
    const float* SS; const float* SA; const float* SB; bf16_t* OUT; int nsc; LAS float* rsc; mutable int rsc_pm;
    __device__ __forceinline__ bool next(int i, Unit& u) const {
        long L;
        if (nsc == 0) L = (long)i * G + c;
        else { if (c < nsc) return false; L = (long)i * (G - nsc) + (c - nsc); }
        if (L >= (long)nM * nN) return false; pg8::static_unit((int)L, nM, nN, u); u.pm += pm0; u.z = 0; return true; }
    __device__ __forceinline__ void mid(Acc&, const Unit&, int, int, int, int) const {}
    __device__ __forceinline__ void epi(Acc& acc, const Unit& u, int wr, int wc, int fr, int fq, int, int) const {
        const int row0 = u.pm * 256 + wr * 64 + fr, col0 = u.pn * 128 + wc * 32 + 8 * fq, bc0 = u.pn * 256 + wc * 32 + 8 * fq;
        float rsv[8];
        if (rsc_pm != u.pm) {
#pragma unroll
            for (int q = 0; q < 8; ++q) { const int row = row0 + (q >> 2) * 128 + (q & 3) * 16; rsv[q] = SA[row] / sqrtf(SS[row] * (1.0f / D) + EPS); }
            *(LAS f32x4*)rsc = (f32x4){rsv[0], rsv[1], rsv[2], rsv[3]}; *(LAS f32x4*)(rsc + 4) = (f32x4){rsv[4], rsv[5], rsv[6], rsv[7]}; rsc_pm = u.pm;
        } else { const f32x4 a = *(const LAS f32x4*)rsc, b = *(const LAS f32x4*)(rsc + 4); rsv[0] = a[0]; rsv[1] = a[1]; rsv[2] = a[2]; rsv[3] = a[3]; rsv[4] = b[0]; rsv[5] = b[1]; rsv[6] = b[2]; rsv[7] = b[3]; }
        const f32x4 sg0 = *(const f32x4*)(SB + bc0), sg1 = *(const f32x4*)(SB + bc0 + 4), su0 = *(const f32x4*)(SB + bc0 + 128), su1 = *(const f32x4*)(SB + bc0 + 132);
        const f32x2 sg[4] = {(f32x2){sg0[0], sg0[1]}, (f32x2){sg0[2], sg0[3]}, (f32x2){sg1[0], sg1[1]}, (f32x2){sg1[2], sg1[3]}};
        const f32x2 su[4] = {(f32x2){su0[0], su0[1]}, (f32x2){su0[2], su0[3]}, (f32x2){su1[0], su1[1]}, (f32x2){su1[2], su1[3]}};
#pragma unroll
        for (int ai = 0; ai < 2; ++ai)
#pragma unroll
            for (int m = 0; m < 4; ++m) { const int row = row0 + ai * 128 + m * 16;
                const float rf = rsv[ai * 4 + m];
                const f32x2 rf2 = (f32x2){rf, rf}, c1 = (f32x2){-1.44269504089f, -1.44269504089f}, one = (f32x2){1.0f, 1.0f};
                f32x4 o[2];
#pragma unroll
                for (int n = 0; n < 2; ++n)
#pragma unroll
                    for (int j = 0; j < 4; j += 2) {
                        const i32x4 gi = __builtin_bit_cast(i32x4, acc[ai][0][m][n]), ui = __builtin_bit_cast(i32x4, acc[ai][1][m][n]);
                        const f32x2 g = ((f32x2){(float)gi[j], (float)gi[j + 1]} * sg[2 * n + (j >> 1)]) * rf2, up = ((f32x2){(float)ui[j], (float)ui[j + 1]} * su[2 * n + (j >> 1)]) * rf2;
                        const f32x2 e = c1 * g; f32x2 t; t.x = fast_exp2(e.x); t.y = fast_exp2(e.y);
                        const f32x2 d = t + one; f32x2 r; r.x = fast_rcp(d.x); r.y = fast_rcp(d.y);
                        const f32x2 q = (g * up) * r; o[n][j] = q.x; o[n][j + 1] = q.y; }
                st_bf16x8(OUT + (size_t)row * FF + col0, o[0], o[1]); }
    }
};

constexpr int VT_LD = 72, KT_LD = 136, BC_LD = 136, OT_LD = 132;
constexpr int L_BC = 0;
constexpr int L_KT = 34816;
constexpr int L_QT = L_KT + 17408;
constexpr int L_VT = L_QT + 17408;
constexpr int L_PT = L_VT + 18432;
constexpr int L_REF = L_PT + 18432;
static_assert(L_REF + 512 <= RING_BYTES, "thin-phase LDS");

struct HItem { int row0, nvalid, h, slot, sidx; };
__device__ __forceinline__ HItem hitem(int item) {
    HItem it; it.slot = item;
    if (item < NSLOT_P) { const int b = item >> 11, c = item & 127; it.h = (item >> 7) & 15; it.row0 = b * SEQ + 64 * c; it.nvalid = 64; it.sidx = -1; }
    else { const int j = item - NSLOT_P; it.sidx = j >> 4; it.h = j & 15; it.row0 = MP + DECS * it.sidx; it.nvalid = DECS; }
    return it;
}
__device__ __forceinline__ void hgrn_load_lg(const float* LOGF, const HItem& it, int ch, int kb, float (&lg)[2][8]) {
#pragma unroll
    for (int j = 0; j < 2; ++j)
#pragma unroll
        for (int i = 0; i < 8; ++i) { const int s = 32 * j + 8 * kb + i; lg[j][i] = (s < it.nvalid) ? LOGF[(size_t)(it.row0 + s) * HGW + it.h * DK + ch] : 0.f; }
}
__device__ __forceinline__ void hgrn_scan(const float (&lg)[2][8], int r, int kb, float (&b)[2][8], float& blast) {
    float T[2];
#pragma unroll
    for (int j = 0; j < 2; ++j) { float a = 0.f;
#pragma unroll
        for (int i = 0; i < 8; ++i) { a += lg[j][i]; b[j][i] = a; } T[j] = a; }
    float t0[4], t1[4];
#pragma unroll
    for (int k = 0; k < 4; ++k) { t0[k] = __shfl(T[0], r + 16 * k); t1[k] = __shfl(T[1], r + 16 * k); }
    float off0 = 0.f, off1 = 0.f;
#pragma unroll
    for (int k = 0; k < 4; ++k) { if (k < kb) { off0 += t0[k]; off1 += t1[k]; } }
    const float tot0 = (t0[0] + t0[1]) + (t0[2] + t0[3]), tot1 = (t1[0] + t1[1]) + (t1[2] + t1[3]);
    off1 += tot0; blast = tot0 + tot1;
#pragma unroll
    for (int i = 0; i < 8; ++i) { b[0][i] += off0; b[1][i] += off1; }
}
__device__ __forceinline__ void hgrn_load_v(const bf16_t* PROJ, const HItem& it, int tid, u32x4 (&vw)[2]) {
#pragma unroll
    for (int q = 0; q < 2; ++q) { const int c = tid + q * 512, s = c >> 4, v0 = (c & 15) * 8;
        vw[q] = (u32x4){0u, 0u, 0u, 0u};
        if (s < it.nvalid) vw[q] = *(const u32x4*)(PROJ + (size_t)(it.row0 + s) * PW + PC_IV + it.h * DV + v0); }
}
__device__ __forceinline__ void hgrn_store_vt(const u32x4 (&vw)[2], LAS bf16_t* VT, int tid) {
#pragma unroll
    for (int q = 0; q < 2; ++q) { const int c = tid + q * 512, s = c >> 4, v0 = (c & 15) * 8; const unsigned ww[4] = {vw[q].x, vw[q].y, vw[q].z, vw[q].w};
#pragma unroll
        for (int i = 0; i < 4; ++i) { VT[(v0 + 2 * i) * VT_LD + s] = (bf16_t)(ww[i] & 0xffffu); VT[(v0 + 2 * i + 1) * VT_LD + s] = (bf16_t)(ww[i] >> 16); } }
}

struct ALoad { float lg[2][8]; u32x4 vw[2]; };
__device__ __forceinline__ void hgrn_a_load(Frame& F, int item, ALoad& L) {
    const HItem it = hitem(item);
    hgrn_load_lg((const float*)(F.ws + WS_LOGF), it, 16 * F.wave + (F.lane & 15), F.lane >> 4, L.lg);
    hgrn_load_v((const bf16_t*)(F.ws + WS_PROJ), it, F.tid, L.vw);
}
__device__ __forceinline__ void hgrn_a_compute(Frame& F, int item, const ALoad& L) {
    const HItem it = hitem(item);
    unsigned char* ws = F.ws;
    float* DEC = (float*)(ws + WS_DEC) + (size_t)it.slot * DK;
    bf16_t* SB16 = (bf16_t*)(ws + WS_ST) + (size_t)it.slot * DK * DV;
    LAS bf16_t* VT = (LAS bf16_t*)(F.lds + L_VT);
    const int w = F.wave, r = F.lane & 15, kb = F.lane >> 4, ch = 16 * w + r;
    float b[2][8], blast;
    hgrn_scan(L.lg, r, kb, b, blast);
    hgrn_store_vt(L.vw, VT, F.tid);
    bf16x8 kf[2];
#pragma unroll
    for (int j = 0; j < 2; ++j) { unsigned pk[4];
#pragma unroll
        for (int i = 0; i < 4; ++i) { const float k0 = (1.0f - fast_exp2(L.lg[j][2 * i])) * fast_exp2(blast - b[j][2 * i]), k1 = (1.0f - fast_exp2(L.lg[j][2 * i + 1])) * fast_exp2(blast - b[j][2 * i + 1]); pk[i] = pk2(k0, k1); }
        kf[j] = __builtin_bit_cast(bf16x8, (u32x4){pk[0], pk[1], pk[2], pk[3]}); }
    if (kb == 0) DEC[ch] = fast_exp2(blast);
    float dk4[4];
#pragma unroll
    for (int i = 0; i < 4; ++i) dk4[i] = fast_exp2(__shfl(blast, 4 * kb + i));
    __syncthreads();
#pragma unroll
    for (int n = 0; n < 8; ++n) { f32x4 acc = (f32x4){0.f, 0.f, 0.f, 0.f};
#pragma unroll
        for (int j = 0; j < 2; ++j) { const bf16x8 vf = *(const LAS bf16x8*)(VT + (16 * n + r) * VT_LD + 32 * j + 8 * kb); acc = __builtin_amdgcn_mfma_f32_16x16x32_bf16(kf[j], vf, acc, 0, 0, 0); }
        const int v = 16 * n + r, k0 = 16 * w + 4 * kb;
        if (it.sidx < 0) { u32x2 dw; dw.x = pk2(acc[0], acc[1]); dw.y = pk2(acc[2], acc[3]); *(u32x2*)(SB16 + (size_t)v * DK + k0) = dw; }
        else { const float* S0 = F.in[I_SH] + ((size_t)it.sidx * NH + it.h) * DK * DV; float* SO = F.out + O_HS + ((size_t)it.sidx * NH + it.h) * DK * DV; f32x4 s0;
#pragma unroll
            for (int i = 0; i < 4; ++i) { s0[i] = S0[(size_t)(k0 + i) * DV + v]; SO[(size_t)(k0 + i) * DV + v] = dk4[i] * s0[i] + acc[i]; }
            u32x2 sw; sw.x = pk2(s0[0], s0[1]); sw.y = pk2(s0[2], s0[3]); *(u32x2*)(SB16 + (size_t)v * DK + k0) = sw; } }
    __syncthreads();
}

__device__ __forceinline__ void conv_item(Frame& F, int item) {
    bf16_t* PROJ = (bf16_t*)(F.ws + WS_PROJ); const float* cw = F.in[I_CONVW];
    const int cchunk = F.tid & 255, half = F.tid >> 8, c0 = cchunk * 8, rbeg = item * 64 + half * 32;
    float w0[8], w1[8], w2[8];
#pragma unroll
    for (int i = 0; i < 8; ++i) { w0[i] = cw[c0 + i]; w1[i] = cw[CW + c0 + i]; w2[i] = cw[2 * CW + c0 + i]; }
    float um2[8], um1[8];
    bool seq_start; const float* cbuf = nullptr;
    if (rbeg < MP) seq_start = (rbeg & (SEQ - 1)) == 0; else { seq_start = true; cbuf = F.in[I_SC] + (size_t)((rbeg - MP) >> 5) * 2 * CW; }
    if (seq_start) {
#pragma unroll
        for (int i = 0; i < 8; ++i) { um2[i] = cbuf ? cbuf[c0 + i] : 0.f; um1[i] = cbuf ? cbuf[CW + c0 + i] : 0.f; }
    } else { const u32x4 a = *(const u32x4*)(PROJ + (size_t)(rbeg - 2) * PW + PC_U + c0), b = *(const u32x4*)(PROJ + (size_t)(rbeg - 1) * PW + PC_U + c0);
        um2[0] = bf_lo(a.x); um2[1] = bf_hi(a.x); um2[2] = bf_lo(a.y); um2[3] = bf_hi(a.y); um2[4] = bf_lo(a.z); um2[5] = bf_hi(a.z); um2[6] = bf_lo(a.w); um2[7] = bf_hi(a.w);
        um1[0] = bf_lo(b.x); um1[1] = bf_hi(b.x); um1[2] = bf_lo(b.y); um1[3] = bf_hi(b.y); um1[4] = bf_lo(b.z); um1[5] = bf_hi(b.z); um1[6] = bf_lo(b.w); um1[7] = bf_hi(b.w); }
#pragma unroll 4
    for (int t = 0; t < 32; ++t) { const size_t ro = (size_t)(rbeg + t) * PW;
        const u32x4 uu = *(const u32x4*)(PROJ + ro + PC_U + c0), cb = *(const u32x4*)(PROJ + ro + PC_CB + c0);
        float u[8], c[8];
        u[0] = bf_lo(uu.x); u[1] = bf_hi(uu.x); u[2] = bf_lo(uu.y); u[3] = bf_hi(uu.y); u[4] = bf_lo(uu.z); u[5] = bf_hi(uu.z); u[6] = bf_lo(uu.w); u[7] = bf_hi(uu.w);
        c[0] = bf_lo(cb.x); c[1] = bf_hi(cb.x); c[2] = bf_lo(cb.y); c[3] = bf_hi(cb.y); c[4] = bf_lo(cb.z); c[5] = bf_hi(cb.z); c[6] = bf_lo(cb.w); c[7] = bf_hi(cb.w);
        float o[8];
#pragma unroll
        for (int i = 0; i < 8; ++i) { o[i] = c[i] * (w0[i] * um2[i] + w1[i] * um1[i] + w2[i] * u[i]); um2[i] = um1[i]; um1[i] = u[i]; }
        u32x4 ow; ow.x = pk2(o[0], o[1]); ow.y = pk2(o[2], o[3]); ow.z = pk2(o[4], o[5]); ow.w = pk2(o[6], o[7]);
        *(u32x4*)(PROJ + ro + PC_CB + c0) = ow; }
}

__device__ __forceinline__ void hgrn_b(Frame& F) {
    const float* DEC = (const float*)(F.ws + WS_DEC); bf16_t* SB16 = (bf16_t*)(F.ws + WS_ST);
    for (int g = F.bid * 512 + F.tid; g < NB * NH * (DK * DV / 4); g += F.G * 512) {
        const int bh = g >> 12, e4 = g & 4095, v = e4 >> 5, k0 = (e4 & 31) * 4;
        u32x2* sp = (u32x2*)(SB16 + (size_t)bh * NCHUNK * DK * DV + (size_t)v * DK + k0); const f32x4* dp = (const f32x4*)(DEC + (size_t)bh * NCHUNK * DK + k0);
        f32x4 s = (f32x4){0.f, 0.f, 0.f, 0.f};
        for (int c0 = 0; c0 < NCHUNK; c0 += 8) { u32x2 t[8]; f32x4 d[8];
#pragma unroll
            for (int i = 0; i < 8; ++i) { t[i] = sp[(size_t)(c0 + i) * (DK * DV / 4)]; d[i] = dp[(size_t)(c0 + i) * (DK / 4)]; }
#pragma unroll
            for (int i = 0; i < 8; ++i) { u32x2 sw; sw.x = pk2(s[0], s[1]); sw.y = pk2(s[2], s[3]); sp[(size_t)(c0 + i) * (DK * DV / 4)] = sw;
                s = d[i] * s + (f32x4){bf_lo(t[i].x), bf_hi(t[i].x), bf_lo(t[i].y), bf_hi(t[i].y)}; } }
        float* o = F.out + O_HP + (size_t)bh * DK * DV;
#pragma unroll
        for (int i = 0; i < 4; ++i) o[(size_t)(k0 + i) * DV + v] = s[i];
    }
}

struct CLoad { float lg[2][8]; u32x4 qw[2], vw[2], ogw[2], st[4]; };
__device__ __forceinline__ void hgrn_c_load(Frame& F, int item, CLoad& L) {
    const HItem it = hitem(item); const int tid = F.tid;
    const bf16_t* PROJ = (const bf16_t*)(F.ws + WS_PROJ); const bf16_t* SB16 = (const bf16_t*)(F.ws + WS_ST) + (size_t)it.slot * DK * DV;
#pragma unroll
    for (int j = 0; j < 4; ++j) L.st[j] = *(const u32x4*)(SB16 + (size_t)(tid + 512 * j) * 8);
#pragma unroll
    for (int q = 0; q < 2; ++q) { const int c = tid + q * 512, t = c >> 4, k0 = (c & 15) * 8; L.qw[q] = (u32x4){0u, 0u, 0u, 0u}; L.vw[q] = L.qw[q]; L.ogw[q] = L.qw[q];
        if (t < it.nvalid) { const bf16_t* rp = PROJ + (size_t)(it.row0 + t) * PW + it.h * DK + k0; L.qw[q] = *(const u32x4*)(rp + PC_Q); L.vw[q] = *(const u32x4*)(rp + PC_IV); L.ogw[q] = *(const u32x4*)(rp + PC_OG); } }
    hgrn_load_lg((const float*)(F.ws + WS_LOGF), it, 16 * F.wave + (F.lane & 15), F.lane >> 4, L.lg);
}
__device__ __forceinline__ void hgrn_c_compute(Frame& F, int item, const CLoad& L) {
    const HItem it = hitem(item);
    unsigned char* ws = F.ws; bf16_t* PROJ = (bf16_t*)(ws + WS_PROJ);
    LAS float* BC = (LAS float*)(F.lds + L_BC); LAS bf16_t* SL = (LAS bf16_t*)(F.lds + L_BC); LAS bf16_t* KT = (LAS bf16_t*)(F.lds + L_KT); LAS bf16_t* QT = (LAS bf16_t*)(F.lds + L_QT);
    LAS float* OT = (LAS float*)(F.lds + L_KT);
    LAS bf16_t* VT = (LAS bf16_t*)(F.lds + L_VT); LAS bf16_t* PT = (LAS bf16_t*)(F.lds + L_PT) + F.wave * 16 * VT_LD; LAS float* REF = (LAS float*)(F.lds + L_REF);
    const int w = F.wave, r = F.lane & 15, kb = F.lane >> 4, tid = F.tid;
    {
        const int ch = 16 * w + r;
        float b[2][8], blast;
        hgrn_scan(L.lg, r, kb, b, blast);
        const float ref = __shfl(b[0][7], r + 48);
#pragma unroll
        for (int j = 0; j < 2; ++j)
#pragma unroll
            for (int i = 0; i < 8; ++i) { const int s = 32 * j + 8 * kb + i; BC[s * BC_LD + ch] = b[j][i];
                KT[s * KT_LD + ch] = (bf16_t)f2bf((1.0f - fast_exp2(L.lg[j][i])) * fast_exp2(ref - b[j][i])); }
        if (kb == 0) REF[ch] = ref;
#pragma unroll
        for (int q = 0; q < 2; ++q) { const int c = tid + q * 512, s = c >> 4, v0 = (c & 15) * 8; const unsigned ww[4] = {L.vw[q].x, L.vw[q].y, L.vw[q].z, L.vw[q].w};
#pragma unroll
            for (int i = 0; i < 4; ++i) { VT[(v0 + 2 * i) * VT_LD + s] = (bf16_t)(ww[i] & 0xffffu); VT[(v0 + 2 * i + 1) * VT_LD + s] = (bf16_t)(ww[i] >> 16); } }
    }
    __syncthreads();
    {
#pragma unroll
        for (int q = 0; q < 2; ++q) { const int c = tid + q * 512, t = c >> 4, k0 = (c & 15) * 8;
            const f32x4 b0 = *(const LAS f32x4*)(BC + t * BC_LD + k0), b1 = *(const LAS f32x4*)(BC + t * BC_LD + k0 + 4), r0 = *(const LAS f32x4*)(REF + k0), r1 = *(const LAS f32x4*)(REF + k0 + 4);
            u32x4 o;
            o.x = pk2(bf_lo(L.qw[q].x) * fast_exp2(b0[0] - r0[0]), bf_hi(L.qw[q].x) * fast_exp2(b0[1] - r0[1])); o.y = pk2(bf_lo(L.qw[q].y) * fast_exp2(b0[2] - r0[2]), bf_hi(L.qw[q].y) * fast_exp2(b0[3] - r0[3]));
            o.z = pk2(bf_lo(L.qw[q].z) * fast_exp2(b1[0] - r1[0]), bf_hi(L.qw[q].z) * fast_exp2(b1[1] - r1[1])); o.w = pk2(bf_lo(L.qw[q].w) * fast_exp2(b1[2] - r1[2]), bf_hi(L.qw[q].w) * fast_exp2(b1[3] - r1[3]));
            *(LAS u32x4*)(QT + t * KT_LD + k0) = o; }
    }
    __syncthreads();
    {
#pragma unroll
        for (int j = 0; j < 4; ++j) { const int e = tid + 512 * j, v = e >> 4, k8 = (e & 15) * 8; const f32x4 r0 = *(const LAS f32x4*)(REF + k8), r1 = *(const LAS f32x4*)(REF + k8 + 4);
            u32x4 o; o.x = pk2(bf_lo(L.st[j].x) * fast_exp2(r0[0]), bf_hi(L.st[j].x) * fast_exp2(r0[1])); o.y = pk2(bf_lo(L.st[j].y) * fast_exp2(r0[2]), bf_hi(L.st[j].y) * fast_exp2(r0[3]));
            o.z = pk2(bf_lo(L.st[j].z) * fast_exp2(r1[0]), bf_hi(L.st[j].z) * fast_exp2(r1[1])); o.w = pk2(bf_lo(L.st[j].w) * fast_exp2(r1[2]), bf_hi(L.st[j].w) * fast_exp2(r1[3]));
            *(LAS u32x4*)(SL + v * KT_LD + k8) = o; }
    }
    const int tb = w & 3, vh = w >> 2;
    bf16x8 af[4], pf[2];
    {
#pragma unroll
        for (int kc = 0; kc < 4; ++kc) af[kc] = *(const LAS bf16x8*)(QT + (16 * tb + r) * KT_LD + 32 * kc + 8 * kb);
#pragma unroll
        for (int sb = 0; sb < 4; ++sb) { f32x4 p = (f32x4){0.f, 0.f, 0.f, 0.f};
            if (sb <= tb) {
#pragma unroll
                for (int kc = 0; kc < 4; ++kc) { const bf16x8 kf = *(const LAS bf16x8*)(KT + (16 * sb + r) * KT_LD + 32 * kc + 8 * kb); p = __builtin_amdgcn_mfma_f32_16x16x32_bf16(af[kc], kf, p, 0, 0, 0); } }
#pragma unroll
            for (int i = 0; i < 4; ++i) { const bool keep = (sb < tb) || (sb == tb && r <= 4 * kb + i); PT[(4 * kb + i) * VT_LD + 16 * sb + r] = (bf16_t)f2bf(keep ? p[i] : 0.f); } }
        LDS_WAIT(); asm volatile("" ::: "memory");
#pragma unroll
        for (int j = 0; j < 2; ++j) pf[j] = *(const LAS bf16x8*)(PT + r * VT_LD + 32 * j + 8 * kb);
    }
    __syncthreads();
    {
#pragma unroll
        for (int n = 0; n < 4; ++n) { const int v = 64 * vh + 16 * n + r; f32x4 acc = (f32x4){0.f, 0.f, 0.f, 0.f};
#pragma unroll
            for (int kc = 0; kc < 4; ++kc) { const bf16x8 sf = *(const LAS bf16x8*)(SL + v * KT_LD + 32 * kc + 8 * kb); acc = __builtin_amdgcn_mfma_f32_16x16x32_bf16(af[kc], sf, acc, 0, 0, 0); }
#pragma unroll
            for (int j = 0; j < 2; ++j) { const bf16x8 vf = *(const LAS bf16x8*)(VT + v * VT_LD + 32 * j + 8 * kb); acc = __builtin_amdgcn_mfma_f32_16x16x32_bf16(pf[j], vf, acc, 0, 0, 0); }
#pragma unroll
            for (int i = 0; i < 4; ++i) OT[(16 * tb + 4 * kb + i) * OT_LD + v] = acc[i]; }
    }
    __syncthreads();
    {
        const float* hg = F.in[I_HGN] + it.h * DV;
#pragma unroll
        for (int q = 0; q < 2; ++q) { const int c = tid + q * 512, t = c >> 4, v0 = (c & 15) * 8;
            const f32x4 o0 = *(const LAS f32x4*)(OT + t * OT_LD + v0), o1 = *(const LAS f32x4*)(OT + t * OT_LD + v0 + 4);
            float ss = (o0[0] * o0[0] + o0[1] * o0[1]) + (o0[2] * o0[2] + o0[3] * o0[3]) + (o1[0] * o1[0] + o1[1] * o1[1]) + (o1[2] * o1[2] + o1[3] * o1[3]);
            ss += __shfl_xor(ss, 1); ss += __shfl_xor(ss, 2); ss += __shfl_xor(ss, 4); ss += __shfl_xor(ss, 8);
            const float rs = 1.0f / sqrtf(ss * (1.0f / DV) + EPS);
            if (t < it.nvalid) { const size_t ro = (size_t)(it.row0 + t) * PW + it.h * DV + v0;
                const u32x4 og = L.ogw[q]; const f32x4 g0 = *(const f32x4*)(hg + v0), g1 = *(const f32x4*)(hg + v0 + 4);
                u32x4 ow;
                ow.x = pk2(o0[0] * rs * g0[0] * bf_lo(og.x), o0[1] * rs * g0[1] * bf_hi(og.x)); ow.y = pk2(o0[2] * rs * g0[2] * bf_lo(og.y), o0[3] * rs * g0[3] * bf_hi(og.y));
                ow.z = pk2(o1[0] * rs * g1[0] * bf_lo(og.z), o1[1] * rs * g1[1] * bf_hi(og.z)); ow.w = pk2(o1[2] * rs * g1[2] * bf_lo(og.w), o1[3] * rs * g1[3] * bf_hi(og.w));
                *(u32x4*)(PROJ + ro + PC_Q) = ow; } }
    }
    __syncthreads();
}

__device__ __forceinline__ void final_norm(Frame& F) {
    const float* SS = (const float*)(F.ws + WS_SS3); const f32x4* g4 = (const f32x4*)F.in[I_NFIN]; const bf16_t* X3 = (const bf16_t*)(F.ws + WS_X1B);
    const f32x4 ga = g4[2 * F.tid], gb = g4[2 * F.tid + 1];
    for (int row = F.bid; row < M; row += 4 * F.G) { u32x4 xw[4]; float ssv[4];
#pragma unroll
        for (int q = 0; q < 4; ++q) { const int rw = row + q * F.G; if (rw < M) { xw[q] = *(const u32x4*)(X3 + (size_t)rw * D + 8 * F.tid); ssv[q] = SS[rw]; } }
#pragma unroll
        for (int q = 0; q < 4; ++q) { const int rw = row + q * F.G; if (rw < M) { const float rs = 1.0f / sqrtf(ssv[q] * (1.0f / D) + EPS);
            f32x4* y = (f32x4*)(F.out + O_Y + (size_t)rw * D) + 2 * F.tid;
            y[0] = (f32x4){bf_lo(xw[q].x), bf_hi(xw[q].x), bf_lo(xw[q].y), bf_hi(xw[q].y)} * rs * ga; y[1] = (f32x4){bf_lo(xw[q].z), bf_hi(xw[q].z), bf_lo(xw[q].w), bf_hi(xw[q].w)} * rs * gb; } } }
}

constexpr int N_PHASES = 14;
__global__ void __launch_bounds__(NWAVES * 64, 2) mk_fwd(Args args) {
    extern __shared__ __attribute__((aligned(16))) unsigned char lds_raw[];
    Frame F;
    F.lds = (LAS unsigned char*)lds_raw;
    F.tid = threadIdx.x; F.lane = F.tid & 63; F.wave = __builtin_amdgcn_readfirstlane(F.tid >> 6);
    F.G = gridDim.x; F.bid = blockIdx.x;
    F.in = args.in; F.out = args.out; F.ws = args.ws;
    volatile LAS unsigned* MISC = (volatile LAS unsigned*)(F.lds + MISC_OFF);
    if (F.tid < 64) MISC[F.tid] = 0u;
    __syncthreads();
    unsigned* ctl = (unsigned*)(args.ws + WS_CTL);
    XcdBarrier bar; bar.bar = ctl + CW_BAR; bar.x = 0; bar.st = nullptr;
#if MK_ONE_LAUNCH
    bar = xcd_barrier_post(ctl + CW_BAR, MISC + 8);
#endif
    const int lo = args.ph_lo, hi = args.ph_hi;
#ifndef PH_MASK
#define PH_MASK 0xffff
#endif
#define IN(k) (((PH_MASK >> (k)) & 1) && lo <= (k) && (k) < hi)
#define SEAM(k) do { if (IN(k) && IN((k) + 1)) xcd_barrier(bar); } while (0)
    unsigned char* ws = args.ws;
#define PHASE_WS() do { unsigned char* _w = args.ws; asm volatile("" : "+s"(_w)); F.ws = _w; ws = _w; } while (0)
    const int G = F.G, c = F.bid;

    if (IN(0)) { PHASE_WS(); p0_prologue(F); xcd_barrier(bar); q8_quant(F, 0, NIT_Q8, c * NWAVES + F.wave, G * NWAVES); } SEAM(0);

    if (IN(1)) { PHASE_WS();
        P1Prob P; P.A = (const char*)(ws + WS_XB); P.B = (const char*)(ws + WS_WIN + (size_t)2048 * D * 2); P.A2 = (const char*)(ws + WS_MEMB); P.B2 = (const char*)(ws + WS_WKV);
        P.lda = D * 2; P.ldb = D * 2; P.nt = D / 64; P.G = G; P.c = c;
        P.PROJ = (bf16_t*)(ws + WS_PROJ); P.LOGF = (float*)(ws + WS_LOGF); P.LB = (const float*)(ws + WS_LB); P.out = F.out; P.MKB = (bf16_t*)(ws + WS_MKB); P.MVB = (bf16_t*)(ws + WS_MVB);
        P.nsc = 0; P.R = 0;
        pg8::gemm_phase(F.lds, P);
        constexpr int P1_UNITS = 65 * 32 + 64;
        const int rounds = (P1_UNITS + G - 1) / G, busy = P1_UNITS - (rounds - 1) * G;
        if (busy < G) { if (c >= busy) convert_items(F, NIT_P0, NIT_W, (c - busy) * NWAVES + F.wave, (G - busy) * NWAVES); }
        else convert_items(F, NIT_P0, NIT_W, c * NWAVES + F.wave, G * NWAVES);
        __syncthreads();
        P1bProb Q; Q.A = (const char*)(ws + WS_XBQ); Q.B = (const char*)(ws + WS_WIN8); Q.lda = D; Q.ldb = D; Q.nt = D / 128; Q.G = G; Q.c = c; Q.nM = M / 256; Q.nN = 56; Q.pm0 = 0;
        Q.SA = (const float*)(ws + WS_SAI); Q.SB = (const float*)(ws + WS_SBI); Q.PROJ = (bf16_t*)(ws + WS_PROJ); Q.rsc = (LAS float*)(F.lds + RSC_OFF) + F.tid * 8; Q.rsc_pm = -1;
        pg8::gemm_phase(F.lds, Q);
    } SEAM(1);

    if (IN(2)) { PHASE_WS();
        {
            PreProb R; R.MKB = (const char*)(ws + WS_MKB); R.MVB = (const char*)(ws + WS_MVB); R.WXQRM = (const char*)(ws + WS_WXQRM); R.WXOT = (const char*)(ws + WS_WXOT);
            R.WPT = (bf16_t*)(ws + WS_WPT); R.VP = (bf16_t*)(ws + WS_VP); R.lda = D * 2; R.ldb = D * 2; R.nt = XD / 64; R.G = G; R.c = c;
            pg8::gemm_phase(F.lds, R);
        }
        int it = c;
        if (it < NSLOT) { ALoad cur; hgrn_a_load(F, it, cur);
            for (;;) { const int nx = it + G; const bool more = nx < NSLOT; ALoad nl = cur; if (more) hgrn_a_load(F, nx, nl);
                hgrn_a_compute(F, it, cur); it = nx; if (!more) break; cur = nl; } }
        for (; it < NSLOT + M / 64; it += G) conv_item(F, it - NSLOT);
    } SEAM(2);
    if (IN(3)) { PHASE_WS(); hgrn_b(F); } SEAM(3);
    if (IN(4)) { PHASE_WS();
        int it = c;
        if (it < NSLOT) { CLoad cur; hgrn_c_load(F, it, cur);
            for (;;) { const int nx = it + G; const bool more = nx < NSLOT; CLoad nl = cur; if (more) hgrn_c_load(F, nx, nl);
                hgrn_c_compute(F, it, cur); if (!more) break; it = nx; cur = nl; } }
    } SEAM(4);

#define SETUP_P5(P, nM_, pm0_, G_, c_) P5Prob P; P.A = (const char*)(ws + WS_PROJ); P.B = (const char*)(ws + WS_WAB); P.lda = PW * 2; P.ldb = D * 2; P.nt = D / 64; P.G = G_; P.c = c_; P.nM = nM_; P.nN = D / 256; P.pm0 = pm0_; \
        P.PROJ = (const bf16_t*)(ws + WS_PROJ); P.OUT = (bf16_t*)(ws + WS_MERGED)
#define SETUP_P6(P, nM_, pm0_, G_, c_) ResProb<true> P; P.A = (const char*)(ws + WS_MERGED); P.B = (const char*)(ws + WS_WO); P.lda = D * 2; P.ldb = D * 2; P.nt = D / 64; P.G = G_; P.c = c_; P.nM = nM_; P.nN = D / 256; P.pm0 = pm0_; \
        P.resP = F.in[I_XP]; P.resS = F.in[I_XS]; P.XB = (bf16_t*)(ws + WS_X1B); P.SS = (float*)(ws + WS_SS1); P.SA = nullptr; P.SB = nullptr; P.rsc = nullptr; P.rsc_pm = -1
#define SETUP_P7(P, nM_, pm0_, G_, c_) P7Prob P; P.A = (const char*)((unsigned char*)F.out + DO_X1Q); P.B = (const char*)(ws + WS_WXQ); P.lda = D; P.ldb = D; P.nt = D / 128; P.G = G_; P.c = c_; P.nM = nM_; P.nN = D / 256; P.pm0 = pm0_; \
        P.SS = (const float*)(ws + WS_SS1); P.SA = (const float*)(ws + WS_SA1); P.SB = (const float*)(ws + WS_SBQ); P.OUT = (bf16_t*)(ws + WS_QX); P.rsc = (LAS float*)(F.lds + RSC_OFF) + F.tid * 8; P.rsc_pm = -1
#define SETUP_P8(P, L0_, LN_, G_, c_) P8Prob P; P.QX = (const char*)(ws + WS_QX); P.MKB = (const char*)(ws + WS_MKB); P.MKS = (const char*)(ws + WS_MKS); P.lda = D * 2; P.ldb = D * 2; P.nt = XD / 64; P.G = G_; P.c = c_; P.L0 = L0_; P.LN = LN_; \
        P.PB = (bf16_t*)(ws + WS_PB); P.LSUM = (float*)(ws + WS_LSUM); P.ldsx = (LAS float*)(F.lds + LDSX_OFF)
#define SETUP_P9(P, L0_, LN_, G_, c_) P9Prob P; P.PB = (const char*)(ws + WS_PB); P.MVT = (const char*)(ws + WS_VTS); P.VTS = (const char*)(ws + WS_VTS); P.lda = 1024 * 2; P.ldb = NMEM * 2; P.nt = NMEM / 64; P.G = G_; P.c = c_; P.L0 = L0_; P.LN = LN_; P.rsc = (LAS float*)(F.lds + RSC_OFF) + F.tid * 8; P.rsc_key = -1; \
        P.LSUM = (const float*)(ws + WS_LSUM); P.OX = (bf16_t*)(ws + WS_OX)
#define SETUP_P10(P, nM_, pm0_, G_, c_) ResProb<false> P; P.A = (const char*)(ws + WS_OX); P.B = (const char*)(ws + WS_WXOT); P.lda = D * 2; P.ldb = D * 2; P.nt = D / 64; P.G = G_; P.c = c_; P.nM = nM_; P.nN = D / 256; P.pm0 = pm0_; \
        P.resP = nullptr; P.resS = nullptr; P.XB = (bf16_t*)(ws + WS_X1B); P.SS = (float*)(ws + WS_SS2); P.SA = nullptr; P.SB = nullptr; P.rsc = nullptr; P.rsc_pm = -1
#define SETUP_P11(P, nM_, pm0_, G_, c_, nsc_) P11Prob P; P.A = (const char*)(ws + WS_X2Q); P.B = (const char*)(ws + WS_WGU); P.lda = D; P.ldb = D; P.nt = D / 128; P.G = G_; P.c = c_; P.nM = nM_; P.nN = 2 * FF / 256; P.pm0 = pm0_; P.nsc = nsc_; P.rsc = (LAS float*)(F.lds + RSC_OFF) + F.tid * 8; P.rsc_pm = -1; \
        P.SS = (const float*)(ws + WS_SS2); P.SA = (const float*)(ws + WS_SA); P.SB = (const float*)(ws + WS_SB); P.OUT = (bf16_t*)(ws + WS_GU)
#define SETUP_P12(P, nM_, pm0_, G_, c_) ResProb<false> P; P.A = (const char*)(ws + WS_GU); P.B = (const char*)(ws + WS_WD); P.lda = FF * 2; P.ldb = FF * 2; P.nt = FF / 64; P.G = G_; P.c = c_; P.nM = nM_; P.nN = D / 256; P.pm0 = pm0_; \
        P.resP = nullptr; P.resS = nullptr; P.XB = (bf16_t*)(ws + WS_X1B); P.SS = (float*)(ws + WS_SS3); P.SA = nullptr; P.SB = nullptr; P.rsc = nullptr; P.rsc_pm = -1
    constexpr int NPP = MP / 256;
    const int nsc = (G >= 64) ? NSC : 0;

    if (IN(5)) { PHASE_WS(); SETUP_P5(P, NPP, 0, G, c); pg8::gemm_phase(F.lds, P); } SEAM(5);
    if (IN(6)) { PHASE_WS(); SETUP_P6(P, NPP, 0, G, c); pg8::gemm_phase(F.lds, P); } SEAM(6);
    if (IN(7)) {
        PHASE_WS();
        P7sProb P; P.X1 = (const char*)(ws + WS_X1B); P.WPT = (const char*)(ws + WS_WPT); P.lda = D * 2; P.ldb = D * 2; P.nt = D / 64; P.G = G; P.c = c;
        P.SS = (const float*)(ws + WS_SS1); P.PB = (bf16_t*)(ws + WS_PB); P.ldsx = (LAS float*)(F.lds + LDSX_OFF);
        pg8::gemm_phase(F.lds, P);
    } SEAM(7);
    if (IN(10)) {
        PHASE_WS();
        P10sProb P; P.A = (const char*)(ws + WS_PB); P.B = (const char*)(ws + WS_VP); P.lda = XH * NMEM * 2; P.ldb = XH * NMEM * 2; P.nt = XH * NMEM / 64; P.G = G; P.c = c; P.nM = NPP; P.nN = D / 256; P.pm0 = 0;
        P.resP = nullptr; P.resS = nullptr; P.XB = (bf16_t*)(ws + WS_X1B); P.SS = (float*)(ws + WS_SS2); P.SA = nullptr; P.SB = nullptr; P.rsc = nullptr; P.rsc_pm = -1;
        pg8::gemm_phase(F.lds, P);
    } SEAM(10);
    if (IN(11)) { PHASE_WS();
        {
            const bf16_t* X2 = (const bf16_t*)(ws + WS_X1B); unsigned char* XQ = ws + WS_X2Q; float* SAp = (float*)(ws + WS_SA);
            quant_rows(X2, XQ, SAp, 0, MP, c * NWAVES + F.wave, G * NWAVES, F.lane);
            xcd_barrier(bar);
        }
        const int Gs = nsc ? nsc : G;
        if (c < Gs) {
            unsigned* sbw = ctl + CW_SUB; unsigned* tmo = ctl + CW_BAR + XB_TMO; unsigned gen = 0;
            { SETUP_P5(S, 1, NPP, Gs, c); pg8::gemm_phase(F.lds, S); } sub_barrier(sbw, Gs, gen, tmo);
            { SETUP_P6(S, 1, NPP, Gs, c); pg8::gemm_phase(F.lds, S); } sub_barrier(sbw, Gs, gen, tmo);
            quant_rows((const bf16_t*)(ws + WS_X1B), (unsigned char*)F.out + DO_X1Q, (float*)(ws + WS_SA1), MP, M, c * NWAVES + F.wave, Gs * NWAVES, F.lane); sub_barrier(sbw, Gs, gen, tmo);
            { SETUP_P7(S, 1, NPP, Gs, c); pg8::gemm_phase(F.lds, S); } sub_barrier(sbw, Gs, gen, tmo);
            { SETUP_P8(S, 256, 32, Gs, c); pg8::gemm_phase(F.lds, S); } sub_barrier(sbw, Gs, gen, tmo);
            { SETUP_P9(S, 1024, 128, Gs, c); pg8::gemm_phase(F.lds, S); } sub_barrier(sbw, Gs, gen, tmo);
            { SETUP_P10(S, 1, NPP, Gs, c); pg8::gemm_phase(F.lds, S); } sub_barrier(sbw, Gs, gen, tmo);
            { const bf16_t* X2 = (const bf16_t*)(ws + WS_X1B); unsigned char* XQ = ws + WS_X2Q; float* SAp = (float*)(ws + WS_SA);
              quant_rows(X2, XQ, SAp, MP, M, c * NWAVES + F.wave, Gs * NWAVES, F.lane); }
            sub_barrier(sbw, Gs, gen, tmo);
            { SETUP_P11(S, 1, NPP, Gs, c, 0); pg8::gemm_phase(F.lds, S); } sub_barrier(sbw, Gs, gen, tmo);
            { SETUP_P12(S, 1, NPP, Gs, c); pg8::gemm_phase(F.lds, S); }
        }
        SETUP_P11(P, NPP, 0, G, c, nsc); pg8::gemm_phase(F.lds, P);
    } SEAM(11);
    if (IN(12)) { PHASE_WS(); SETUP_P12(P, NPP, 0, G, c); pg8::gemm_phase(F.lds, P); } SEAM(12);

    if (IN(13)) { PHASE_WS(); final_norm(F); }
#undef IN
#undef SEAM
}

extern "C" void kernel_launch(void* const* d_in, const int* in_sizes, int n_in, void* d_out, int out_size, void* d_ws, size_t ws_size, hipStream_t stream) {
    static int grid = 0;
    if (grid == 0) {
        if (n_in != 26 || ws_size < WS_END) { fprintf(stderr, "kernel_launch: unexpected n_in %d / ws_size %zu (need %zu)\n", n_in, ws_size, (size_t)WS_END); grid = -1; return; }
        int dev = 0, cus = 0, per_cu = 0;
        if (hipGetDevice(&dev) != hipSuccess || hipDeviceGetAttribute(&cus, hipDeviceAttributeMultiprocessorCount, dev) != hipSuccess) { grid = -1; return; }
        if (hipFuncSetAttribute((const void*)mk_fwd, hipFuncAttributeMaxDynamicSharedMemorySize, LDS_BYTES) != hipSuccess) { fprintf(stderr, "kernel_launch: hipFuncSetAttribute failed\n"); grid = -1; return; }
        if (hipOccupancyMaxActiveBlocksPerMultiprocessor(&per_cu, (const void*)mk_fwd, NWAVES * 64, LDS_BYTES) != hipSuccess || per_cu < 1) { fprintf(stderr, "kernel_launch: occupancy query says %d\n", per_cu); }
        (void)hipGetLastError();
        grid = cus;
    }
    if (grid < 0) return;
    (void)hipMemsetAsync((char*)d_ws + WS_CTL, 0, CTL_ZERO_BYTES, stream);
    Args a{};
    for (int i = 0; i < 26; ++i) a.in[i] = (const float*)d_in[i];
    a.out = (float*)d_out; a.ws = (unsigned char*)d_ws;
#if MK_ONE_LAUNCH
    a.ph_lo = 0; a.ph_hi = N_PHASES;
    hipLaunchKernelGGL(mk_fwd, dim3(grid), dim3(NWAVES * 64), LDS_BYTES, stream, a);
#else
    for (int p = 0; p < N_PHASES; ++p) { a.ph_lo = p; a.ph_hi = p + 1; hipLaunchKernelGGL(mk_fwd, dim3(grid), dim3(NWAVES * 64), LDS_BYTES, stream, a); }
#endif
}
```
